# Optimizing an MI355X kernel written in HIP

```python
import math
import jax, jax.numpy as jnp
from jax import lax
import numpy as np

D_MODEL = 2048
BATCH = 2
SEQ = 4096
DEPTH = 2
DEC_BATCH = 8
DEC_SEQ = 4
PAST_LEN = 16384
PAGE_SIZE = 128

N_EVEN = (DEPTH + 1) // 2
N_ODD = DEPTH // 2
A_DK = 128
A_DV = 128
A_HEADS = (5 * D_MODEL // 8) // A_DK
A_WIDTH = A_HEADS * A_DK
A_CONV = 4
A_CHUNK = 64
B_CONFIGS = ((128, 1), (512, 4), (2048, 16))
B_NGROUPS = len(B_CONFIGS)
B_HD = 64
B_HPG = (D_MODEL - A_WIDTH) // (B_NGROUPS * B_HD)
B_WIDTH = B_NGROUPS * B_HPG * B_HD
B_QBLOCK = 128
B_SCALE = B_HD ** -0.5
C_WIDTH = D_MODEL
C_CONV = 3
FFN_DIM = 5632
N_MOD = 9
EPS = 1e-6
IN0_DIM = 4 * A_WIDTH + 2 * A_HEADS + 3 * B_WIDTH
MIX0_DIM = A_WIDTH + B_WIDTH

kernel_name = "hybrid_gdn_dilswa_shortconv_step"


def rms_norm(x, gain):
    xf = x.astype(jnp.float32)
    xf = xf * lax.rsqrt(jnp.mean(xf * xf, axis=-1, keepdims=True) + EPS)
    return xf.astype(x.dtype) * gain


def l2_normalize(x):
    xf = x.astype(jnp.float32)
    return xf * lax.rsqrt(jnp.sum(xf * xf, axis=-1, keepdims=True) + EPS)


def modulate(h, shift, scale):
    return h * (1.0 + scale[:, None, :]) + shift[:, None, :]


def swiglu(h, w_up, w_down):
    g, u = jnp.split(h @ w_up, 2, axis=-1)
    return (jax.nn.silu(g) * u) @ w_down


def causal_dwconv(x, buf, w):
    width = w.shape[0]
    L = x.shape[1]
    xp = jnp.concatenate([buf, x], axis=1)
    y = xp[:, 0:L] * w[0]
    for j in range(1, width):
        y = y + xp[:, j:j + L] * w[j]
    return y, xp[:, L:]


def gated_delta_chunked(q, k, v, g, beta, S0, chunk):
    f32 = jnp.float32
    bsz, L, H, K = q.shape
    V = v.shape[-1]
    n = L // chunk

    def blk(t):
        t = t.astype(f32).reshape((bsz, n, chunk, H) + t.shape[3:])
        return jnp.moveaxis(t, (1, 3), (0, 2))

    qc, kc, vc, gc, bc = blk(q), blk(k), blk(v), blk(g), blk(beta)
    gam = jnp.cumsum(gc, axis=-1)
    idx = jnp.arange(chunk)
    causal = idx[:, None] >= idx[None, :]
    strict = idx[:, None] > idx[None, :]
    diff = gam[..., :, None] - gam[..., None, :]
    decay = jnp.where(causal, jnp.exp(jnp.where(causal, diff, 0.0)), 0.0)
    kk = jnp.einsum('nbhik,nbhjk->nbhij', kc, kc)
    tri = jnp.where(strict, bc[..., :, None] * kk * decay, 0.0) + jnp.eye(chunk, dtype=f32)
    rhs = jnp.concatenate([vc * bc[..., None], kc * (bc * jnp.exp(gam))[..., None]], axis=-1)
    sol = lax.linalg.triangular_solve(tri, rhs, left_side=True, lower=True, unit_diagonal=True)
    u_val, w_key = sol[..., :V], sol[..., V:]
    qk = jnp.einsum('nbhik,nbhjk->nbhij', qc, kc) * decay
    q_dec = qc * jnp.exp(gam)[..., None]
    k_dec = kc * jnp.exp(gam[..., -1:] - gam)[..., None]
    g_tot = jnp.exp(gam[..., -1])

    def step(S, xs):
        u_i, w_i, qk_i, qd_i, kd_i, gt_i = xs
        u = u_i - jnp.einsum('bhck,bhkv->bhcv', w_i, S)
        o = jnp.einsum('bhck,bhkv->bhcv', qd_i, S) + jnp.einsum('bhij,bhjv->bhiv', qk_i, u)
        S = S * gt_i[..., None, None] + jnp.einsum('bhck,bhcv->bhkv', kd_i, u)
        return S, o

    S_fin, o = lax.scan(step, S0.astype(f32), (u_val, w_key, qk, q_dec, k_dec, g_tot))
    o = jnp.moveaxis(o, (0, 2), (1, 3)).reshape(bsz, L, H, V)
    return o, S_fin


def dilated_swa(q, k, v, kv_pasts, pos0):
    bsz, L = q.shape[:2]
    qb = math.gcd(L, B_QBLOCK)
    starts = jnp.arange(0, L, qb)
    outs, lses, new_kv = [], [], []
    for g, (win, dil) in enumerate(B_CONFIGS):
        qg = q[:, :, g]
        kv_new = jnp.stack([k[:, :, g], v[:, :, g]], axis=2)
        kv_past = kv_pasts[g]
        n_past = kv_past.shape[1]
        pad = jnp.zeros((bsz, win - n_past) + kv_new.shape[2:], kv_new.dtype)
        kv_full = jnp.concatenate([pad, kv_past, kv_new], axis=1)
        n_keys = win // dil + 1
        qi = jnp.arange(qb)[:, None]
        mi = jnp.arange(n_keys)[None, :]
        loc = win + qi - dil * mi

        def block(i0):
            kv_blk = lax.dynamic_slice_in_dim(kv_full, i0, win + qb, axis=1)
            kv_sel = kv_blk[:, loc]
            q_blk = lax.dynamic_slice_in_dim(qg, i0, qb, axis=1)
            s = jnp.einsum('bqhd,bqmhd->bhqm', q_blk, kv_sel[:, :, :, 0]).astype(jnp.float32) * B_SCALE
            valid = (pos0 + i0 + qi - dil * mi) >= 0
            s = jnp.where(valid, s, -jnp.inf)
            smax = jnp.max(s, axis=-1, keepdims=True)
            p = jnp.exp(s - smax)
            den = jnp.sum(p, axis=-1, keepdims=True)
            o = jnp.einsum('bhqm,bqmhd->bqhd', (p / den).astype(qg.dtype), kv_sel[:, :, :, 1])
            return o, (smax + jnp.log(den))[..., 0]

        o, lse = lax.map(block, starts)
        outs.append(jnp.moveaxis(o, 0, 1).reshape(bsz, L, B_HPG, B_HD))
        lses.append(jnp.transpose(lse, (1, 0, 3, 2)).reshape(bsz, L, B_HPG))
        keep = n_past if n_past > 0 else min(win, L)
        new_kv.append(jnp.concatenate([kv_past, kv_new], axis=1)[:, -keep:])
    alpha = jax.nn.softmax(jnp.stack(lses, axis=0), axis=0)
    y = jnp.concatenate([outs[g] * alpha[g][..., None].astype(outs[g].dtype) for g in range(B_NGROUPS)], axis=2)
    return y.reshape(bsz, L, B_WIDTH), new_kv


def even_mixer(h, pos0, S0, conv_buf, kv_pasts, w_in, conv_w, a_log, dt_bias, onorm, w_out):
    bsz, L, _ = h.shape
    proj = h @ w_in
    qkv_a, z_a, a_a, b_a, qkv_b = jnp.split(
        proj, [3 * A_WIDTH, 4 * A_WIDTH, 4 * A_WIDTH + A_HEADS, 4 * A_WIDTH + 2 * A_HEADS], axis=-1)
    qkv_a, new_conv = causal_dwconv(qkv_a, conv_buf, conv_w)
    qkv_a = jax.nn.silu(qkv_a).reshape(bsz, L, 3, A_HEADS, A_DK)
    q_a = l2_normalize(qkv_a[:, :, 0]) * (A_DK ** -0.5)
    k_a = l2_normalize(qkv_a[:, :, 1])
    v_a = qkv_a[:, :, 2]
    beta = jax.nn.sigmoid(b_a.astype(jnp.float32))
    g_log = -jnp.exp(a_log.astype(jnp.float32)) * jax.nn.softplus(a_a.astype(jnp.float32) + dt_bias.astype(jnp.float32))
    o_a, S_new = gated_delta_chunked(q_a, k_a, v_a, g_log, beta, S0, math.gcd(L, A_CHUNK))
    o_a = rms_norm(o_a.astype(h.dtype), onorm) * jax.nn.silu(z_a.reshape(bsz, L, A_HEADS, A_DV))
    qkv_b = qkv_b.reshape(bsz, L, 3, B_NGROUPS, B_HPG, B_HD)
    o_b, new_kv = dilated_swa(qkv_b[:, :, 0], qkv_b[:, :, 1], qkv_b[:, :, 2], kv_pasts, pos0)
    mix = jnp.concatenate([o_a.reshape(bsz, L, A_WIDTH), o_b], axis=-1) @ w_out
    return mix, S_new.astype(S0.dtype), new_conv, new_kv


def short_conv_mixer(h, conv_buf, w_in, conv_w, w_out):
    bg, cg, xt = jnp.split(h @ w_in, 3, axis=-1)
    y, new_buf = causal_dwconv(cg * xt, conv_buf, conv_w)
    return (bg * y) @ w_out, new_buf


def trunk(x, c, pos0, st_S, st_conv, st_kv, st_sc, p):
    new_S, new_conv, new_sc = [], [], []
    new_kv = [[] for _ in range(B_NGROUPS)]
    for l in range(DEPTH):
        mod = jax.nn.silu(c) @ p['ada_w'][l] + p['ada_b'][l]
        sh1, sc1, g1, sh2, sc2, g2, sh3, sc3, g3 = jnp.split(mod, N_MOD, axis=-1)
        h = modulate(rms_norm(x, p['ln_ffn1'][l]), sh1, sc1)
        x = x + 0.5 * g1[:, None, :] * swiglu(h, p['ffn_w_up'][l, 0], p['ffn_w_down'][l, 0])
        h = modulate(rms_norm(x, p['ln_mix'][l]), sh2, sc2)
        if l % 2 == 0:
            e = l // 2
            mix, S_e, conv_e, kv_e = even_mixer(
                h, pos0, st_S[e], st_conv[e], [kv[e] for kv in st_kv],
                p['w_in0'][e], p['gdn_conv_w'][e], p['gdn_a_log'][e], p['gdn_dt_bias'][e],
                p['gdn_onorm'][e], p['w_out0'][e])
            new_S.append(S_e)
            new_conv.append(conv_e)
            for gi in range(B_NGROUPS):
                new_kv[gi].append(kv_e[gi])
        else:
            o = l // 2
            mix, sc_o = short_conv_mixer(h, st_sc[o], p['sc_w_in'][o], p['sc_conv_w'][o], p['sc_w_out'][o])
            new_sc.append(sc_o)
        x = x + g2[:, None, :] * mix
        h = modulate(rms_norm(x, p['ln_ffn2'][l]), sh3, sc3)
        x = x + 0.5 * g3[:, None, :] * swiglu(h, p['ffn_w_up'][l, 1], p['ffn_w_down'][l, 1])
    y = rms_norm(x, p['ln_final'])
    return (y, jnp.stack(new_S), jnp.stack(new_conv), jnp.stack(new_kv[0]), jnp.stack(new_kv[1]),
            jnp.stack(new_kv[2]), jnp.stack(new_sc))


def setup_inputs(seed: int = 0) -> dict:
    key = jax.random.key(seed)
    ks = iter(jax.random.split(key, 40))
    f32 = jnp.float32

    def nrm(shape, scale):
        return jax.random.normal(next(ks), shape, f32) * scale

    D = D_MODEL
    dt = jnp.exp(jax.random.uniform(next(ks), (N_EVEN, A_HEADS), f32, math.log(1e-3), math.log(1e-1)))
    return {
        'x_prompt': nrm((BATCH, SEQ, D), 1.0),
        'x_sample': nrm((DEC_BATCH, DEC_SEQ, D), 1.0),
        'c_prompt': nrm((BATCH, D), 1.0),
        'c_sample': nrm((DEC_BATCH, D), 1.0),
        'state_gdn_S': nrm((N_EVEN, DEC_BATCH, A_HEADS, A_DK, A_DV), 0.5),
        'state_gdn_conv': nrm((N_EVEN, DEC_BATCH, A_CONV - 1, 3 * A_WIDTH), 1.0),
        'cache_swa_kv_g0': nrm((N_EVEN, DEC_BATCH, min(B_CONFIGS[0][0], PAST_LEN), 2, B_HPG, B_HD), 1.0),
        'cache_swa_kv_g1': nrm((N_EVEN, DEC_BATCH, min(B_CONFIGS[1][0], PAST_LEN), 2, B_HPG, B_HD), 1.0),
        'cache_swa_kv_g2': nrm((N_EVEN, DEC_BATCH, min(B_CONFIGS[2][0], PAST_LEN), 2, B_HPG, B_HD), 1.0),
        'state_sconv': nrm((N_ODD, DEC_BATCH, C_CONV - 1, C_WIDTH), 1.0),
        'ada_w': nrm((DEPTH, D, N_MOD * D), D ** -0.5),
        'ada_b': nrm((DEPTH, N_MOD * D), 0.02),
        'ln_ffn1': 1.0 + nrm((DEPTH, D), 0.05),
        'ln_mix': 1.0 + nrm((DEPTH, D), 0.05),
        'ln_ffn2': 1.0 + nrm((DEPTH, D), 0.05),
        'ln_final': 1.0 + nrm((D,), 0.05),
        'ffn_w_up': nrm((DEPTH, 2, D, 2 * FFN_DIM), D ** -0.5),
        'ffn_w_down': nrm((DEPTH, 2, FFN_DIM, D), FFN_DIM ** -0.5),
        'w_in0': nrm((N_EVEN, D, IN0_DIM), D ** -0.5),
        'gdn_conv_w': nrm((N_EVEN, A_CONV, 3 * A_WIDTH), A_CONV ** -0.5),
        'gdn_a_log': jnp.log(jax.random.uniform(next(ks), (N_EVEN, A_HEADS), f32, 1.0, 16.0)),
        'gdn_dt_bias': dt + jnp.log(-jnp.expm1(-dt)),
        'gdn_onorm': 1.0 + nrm((N_EVEN, A_DV), 0.05),
        'w_out0': nrm((N_EVEN, MIX0_DIM, D), MIX0_DIM ** -0.5),
        'sc_w_in': nrm((N_ODD, D, 3 * C_WIDTH), D ** -0.5),
        'sc_conv_w': nrm((N_ODD, C_CONV, C_WIDTH), C_CONV ** -0.5),
        'sc_w_out': nrm((N_ODD, C_WIDTH, D), C_WIDTH ** -0.5),
    }


def reference(x_prompt, x_sample, c_prompt, c_sample, state_gdn_S, state_gdn_conv,
              cache_swa_kv_g0, cache_swa_kv_g1, cache_swa_kv_g2, state_sconv,
              ada_w, ada_b, ln_ffn1, ln_mix, ln_ffn2, ln_final, ffn_w_up, ffn_w_down,
              w_in0, gdn_conv_w, gdn_a_log, gdn_dt_bias, gdn_onorm, w_out0,
              sc_w_in, sc_conv_w, sc_w_out):
    params = {
        'ada_w': ada_w, 'ada_b': ada_b, 'ln_ffn1': ln_ffn1, 'ln_mix': ln_mix,
        'ln_ffn2': ln_ffn2, 'ln_final': ln_final, 'ffn_w_up': ffn_w_up, 'ffn_w_down': ffn_w_down,
        'w_in0': w_in0, 'gdn_conv_w': gdn_conv_w, 'gdn_a_log': gdn_a_log,
        'gdn_dt_bias': gdn_dt_bias, 'gdn_onorm': gdn_onorm, 'w_out0': w_out0,
        'sc_w_in': sc_w_in, 'sc_conv_w': sc_conv_w, 'sc_w_out': sc_w_out,
    }
    dt = x_prompt.dtype
    bp = x_prompt.shape[0]
    p_S0 = jnp.zeros((N_EVEN, bp, A_HEADS, A_DK, A_DV), dt)
    p_conv0 = jnp.zeros((N_EVEN, bp, A_CONV - 1, 3 * A_WIDTH), dt)
    p_kv0 = [jnp.zeros((N_EVEN, bp, 0, 2, B_HPG, B_HD), dt) for _ in range(B_NGROUPS)]
    p_sc0 = jnp.zeros((N_ODD, bp, C_CONV - 1, C_WIDTH), dt)
    (y_prompt, p_S, p_conv, p_kv_g0, p_kv_g1, p_kv_g2, p_sc) = trunk(
        x_prompt, c_prompt, 0, p_S0, p_conv0, p_kv0, p_sc0, params)
    (y_sample, s_S, s_conv, s_kv_g0, s_kv_g1, s_kv_g2, s_sc) = trunk(
        x_sample, c_sample, PAST_LEN, state_gdn_S, state_gdn_conv,
        [cache_swa_kv_g0, cache_swa_kv_g1, cache_swa_kv_g2], state_sconv, params)
    return (y_prompt, y_sample, p_S, p_conv, p_kv_g0, p_kv_g1, p_kv_g2, p_sc,
            s_S, s_conv, s_kv_g0, s_kv_g1, s_kv_g2, s_sc)
```

```cpp
#include <hip/hip_runtime.h>
#include <cstdio>
#include <cstdint>

#ifndef MK_N_LAUNCHES
#define MK_N_LAUNCHES 1
#endif

namespace pg8 {
#define PG8_LAS __attribute__((address_space(3)))
typedef unsigned short bf16_t;
typedef short bf16x8 __attribute__((ext_vector_type(8)));
typedef float f32x4 __attribute__((ext_vector_type(4)));
typedef unsigned u32x4 __attribute__((ext_vector_type(4)));
constexpr int BM = 256, BK = 64, HALF = 128, HTB = HALF * BK * 2, STAGE_BYTES = 8 * HTB, NXCD = 8, WGM = 8;

__host__ __device__ __forceinline__ int lds_byte(int r, int c) { const int st = (r >> 4) * 2 + (c >> 5), rr = r & 15, cc = c & 31, ob = rr * 64 + cc * 2; return st * 1024 + (ob ^ (((ob >> 9) & 1) << 5)); }
__host__ __device__ __forceinline__ void stage_rc(int b, int& R, int& C) { const int st = b / 1024, sb = b % 1024, swz = sb ^ (((sb >> 9) & 1) << 5); R = (st >> 1) * 16 + swz / 64; C = (st & 1) * 32 + (swz % 64) / 2; }
__host__ __device__ __forceinline__ int perm32(int rho) { const int n = rho >> 4, i = rho & 15; return 8 * (i >> 2) + 4 * n + (i & 3); }

struct Unit { int pm, pn; };
struct Gemm { const bf16_t* A; const bf16_t* Bt; int M, N, K; };

struct StaticOrder {
    int nM, nN, nwg, G, c;
    __host__ __device__ void init(int M, int N, int G_, int c_) { nM = M / BM; nN = N / BM; nwg = nM * nN; G = G_; c = c_; }
    __host__ __device__ bool next(int i, Unit& u) const {
        const long L = (long)i * G + c; if (L >= nwg) return false;
        int wgid = (int)L; { const int q = nwg / NXCD, r = nwg % NXCD, xcd = wgid % NXCD, off = wgid / NXCD; wgid = (xcd < r ? xcd * (q + 1) : r * (q + 1) + (xcd - r) * q) + off; }
        const int nig = WGM * nN, gid = wgid / nig, fm = gid * WGM, gsz = (nM - fm) < WGM ? (nM - fm) : WGM;
        u.pm = fm + ((wgid % nig) % gsz); u.pn = (wgid % nig) / gsz; return true;
    }
    __device__ __forceinline__ void a_ready(const Unit&) const {}
    __device__ __forceinline__ void done(const Unit&) const {}
};

__device__ __forceinline__ unsigned cvt_pk_bf16(float lo, float hi) { unsigned r; asm volatile("v_cvt_pk_bf16_f32 %0, %1, %2" : "=v"(r) : "v"(lo), "v"(hi)); return r; }
__device__ __forceinline__ float silu_f(float x) { return x * __builtin_amdgcn_rcpf(1.0f + __expf(-x)); }

constexpr int E_MV = 8224, E_MPROMPT = 8192, E_D = 2048, E_NMOD = 18432;
__device__ __forceinline__ int seq_of_row(int r) { return r < E_MPROMPT ? (r >> 12) : 2 + ((r - E_MPROMPT) >> 2); }

struct EpiSwiglu {
    static constexpr bool PERM = true, AFTER_DRAIN = false;
    bf16_t* O; int ldc;
    __device__ __forceinline__ void operator()(const f32x4 (&acc)[2][2][4][2], const Unit& u, int wr, int wc, int fr, int fq) const {
        const int row0 = u.pm * BM + wr * 64 + fr, col0 = u.pn * HALF + wc * 32 + 8 * fq;
#pragma unroll
        for (int ai = 0; ai < 2; ++ai)
#pragma unroll
            for (int m = 0; m < 4; ++m) { bf16_t* rowp = O + (size_t)(row0 + ai * HALF + m * 16) * ldc + col0;
                const f32x4 g0 = acc[ai][0][m][0], g1 = acc[ai][0][m][1], u0 = acc[ai][1][m][0], u1 = acc[ai][1][m][1];
                u32x4 w; w.x = cvt_pk_bf16(silu_f(g0[0]) * u0[0], silu_f(g0[1]) * u0[1]); w.y = cvt_pk_bf16(silu_f(g0[2]) * u0[2], silu_f(g0[3]) * u0[3]);
                w.z = cvt_pk_bf16(silu_f(g1[0]) * u1[0], silu_f(g1[1]) * u1[1]); w.w = cvt_pk_bf16(silu_f(g1[2]) * u1[2], silu_f(g1[3]) * u1[3]);
                *(u32x4*)rowp = w; }
    }
};
struct EpiResid {
    static constexpr bool PERM = false, AFTER_DRAIN = false;
    float* X; const float* gate; float scale;
    __device__ __forceinline__ void operator()(const f32x4 (&acc)[2][2][4][2], const Unit& u, int wr, int wc, int fr, int fq) const {
        const int col0 = u.pn * BM + wc * 32 + 4 * fq;
#pragma unroll
        for (int ai = 0; ai < 2; ++ai)
#pragma unroll
            for (int m = 0; m < 4; ++m) { const int r = u.pm * BM + ai * HALF + wr * 64 + m * 16 + fr;
                if (r < E_MV) { const float* gp = gate + (size_t)seq_of_row(r) * E_NMOD + col0; float* xp = X + (size_t)r * E_D + col0;
#pragma unroll
                    for (int bj = 0; bj < 2; ++bj)
#pragma unroll
                        for (int n = 0; n < 2; ++n) { const f32x4 gv = *(const f32x4*)(gp + bj * HALF + n * 16); f32x4 xv = *(const f32x4*)(xp + bj * HALF + n * 16);
                            xv = xv + (gv * scale) * acc[ai][bj][m][n]; *(f32x4*)(xp + bj * HALF + n * 16) = xv; } }
                if (m & 1) asm volatile("" ::: "memory"); }
    }
};
struct EpiIn0 {
    static constexpr bool PERM = true, AFTER_DRAIN = false;
    bf16_t* O; int ldc; float* AB;
    __device__ __forceinline__ void operator()(const f32x4 (&acc)[2][2][4][2], const Unit& u, int wr, int wc, int fr, int fq) const {
        const int row0 = u.pm * BM + wr * 64 + fr;
        if (u.pn < 29) { const int col0 = u.pn * BM + wc * 32 + 8 * fq;
#pragma unroll
            for (int ai = 0; ai < 2; ++ai)
#pragma unroll
                for (int m = 0; m < 4; ++m) { bf16_t* rowp = O + (size_t)(row0 + ai * HALF + m * 16) * ldc + col0;
#pragma unroll
                    for (int bj = 0; bj < 2; ++bj) { const f32x4 v0 = acc[ai][bj][m][0], v1 = acc[ai][bj][m][1];
                        u32x4 w; w.x = cvt_pk_bf16(v0[0], v0[1]); w.y = cvt_pk_bf16(v0[2], v0[3]); w.z = cvt_pk_bf16(v1[0], v1[1]); w.w = cvt_pk_bf16(v1[2], v1[3]);
                        *(u32x4*)(rowp + bj * HALF) = w; } }
        } else if (wc == 0) {
#pragma unroll
            for (int ai = 0; ai < 2; ++ai)
#pragma unroll
                for (int m = 0; m < 4; ++m) { float* rowp = AB + (size_t)(row0 + ai * HALF + m * 16) * 32 + 8 * fq;
                    *(f32x4*)rowp = acc[ai][0][m][0]; *(f32x4*)(rowp + 4) = acc[ai][0][m][1]; }
        }
    }
};
struct EpiIn1 {
    static constexpr bool PERM = true, AFTER_DRAIN = false;
    bf16_t* BG; bf16_t* P;
    __device__ __forceinline__ void operator()(const f32x4 (&acc)[2][2][4][2], const Unit& u, int wr, int wc, int fr, int fq) const {
        const int row0 = u.pm * BM + wr * 64 + fr;
        if (u.pn < 8) { const int col0 = u.pn * BM + wc * 32 + 8 * fq;
#pragma unroll
            for (int ai = 0; ai < 2; ++ai)
#pragma unroll
                for (int m = 0; m < 4; ++m) { bf16_t* rowp = BG + (size_t)(row0 + ai * HALF + m * 16) * E_D + col0;
#pragma unroll
                    for (int bj = 0; bj < 2; ++bj) { const f32x4 v0 = acc[ai][bj][m][0], v1 = acc[ai][bj][m][1];
                        u32x4 w; w.x = cvt_pk_bf16(v0[0], v0[1]); w.y = cvt_pk_bf16(v0[2], v0[3]); w.z = cvt_pk_bf16(v1[0], v1[1]); w.w = cvt_pk_bf16(v1[2], v1[3]);
                        *(u32x4*)(rowp + bj * HALF) = w; } }
        } else { const int col0 = (u.pn - 8) * HALF + wc * 32 + 8 * fq;
#pragma unroll
            for (int ai = 0; ai < 2; ++ai)
#pragma unroll
                for (int m = 0; m < 4; ++m) { bf16_t* rowp = P + (size_t)(row0 + ai * HALF + m * 16) * E_D + col0;
                    const f32x4 a0 = acc[ai][0][m][0], a1 = acc[ai][0][m][1], b0 = acc[ai][1][m][0], b1 = acc[ai][1][m][1];
                    u32x4 w; w.x = cvt_pk_bf16(a0[0] * b0[0], a0[1] * b0[1]); w.y = cvt_pk_bf16(a0[2] * b0[2], a0[3] * b0[3]);
                    w.z = cvt_pk_bf16(a1[0] * b1[0], a1[1] * b1[1]); w.w = cvt_pk_bf16(a1[2] * b1[2], a1[3] * b1[3]);
                    *(u32x4*)rowp = w; }
        }
    }
};

template <class Epi, class Sched, bool ALIGN_EPI = false, bool SP2 = false>
__device__ __forceinline__ void gemm_phase(PG8_LAS unsigned char* lds, const Gemm g, const Sched& S, const Epi& E) {
    const int tid = threadIdx.x, wid = __builtin_amdgcn_readfirstlane(tid >> 6), lane = tid & 63, wr = wid >> 2, wc = wid & 3, fr = lane & 15, fq = lane >> 4;
    const int K = g.K, nt = K / BK;
    unsigned voffA[2], voffB[2];
#pragma unroll
    for (int i = 0; i < 2; ++i) { int R, C; stage_rc(tid * 16 + i * 8192, R, C); const int Rb = Epi::PERM ? ((R & ~31) + perm32(R & 31)) : R;
        voffA[i] = (unsigned)(R * K + C) * 2u; voffB[i] = (unsigned)(Rb * K + C) * 2u; }
    const size_t kstep = (size_t)(BK * 2);
    const size_t hstep = (size_t)HALF * K * 2;
    const size_t tstep = 2 * hstep;
    const unsigned ldsw = (unsigned)wid * 1024u;
    const int aoff = lds_byte(wr * 64 + fr, fq * 8), boff = lds_byte(wc * 32 + fr, fq * 8);
#define PG8_SA(b, h) (((b) * 2 + (h)) * HTB)
#define PG8_SB(b, h) ((4 + (b) * 2 + (h)) * HTB)
#define PG8_STAGE(bufoff, gbase, voff) do { _Pragma("unroll") for (int _i = 0; _i < 2; ++_i) \
        __builtin_amdgcn_global_load_lds((const unsigned*)((const char*)(gbase) + (voff)[_i]), (PG8_LAS unsigned*)(lds + (bufoff) + ldsw + _i * 8192), 16, 0, 0); } while (0)
#define PG8_LDA(dst, b, h) do { _Pragma("unroll") for (int m = 0; m < 4; ++m) _Pragma("unroll") for (int k = 0; k < 2; ++k) dst[m][k] = *(const PG8_LAS bf16x8*)(lds + PG8_SA(b, h) + aoff + m * 2048 + k * 1024); } while (0)
#define PG8_LDB(dst, b, h) do { _Pragma("unroll") for (int n = 0; n < 2; ++n) _Pragma("unroll") for (int k = 0; k < 2; ++k) dst[n][k] = *(const PG8_LAS bf16x8*)(lds + PG8_SB(b, h) + boff + n * 2048 + k * 1024); } while (0)
#define PG8_MMA(ai, bj, At, Bt) do { __builtin_amdgcn_s_setprio(1); _Pragma("unroll") for (int m = 0; m < 4; ++m) _Pragma("unroll") for (int n = 0; n < 2; ++n) _Pragma("unroll") for (int k = 0; k < 2; ++k) \
        acc[ai][bj][m][n] = __builtin_amdgcn_mfma_f32_16x16x32_bf16(Bt[n][k], At[m][k], acc[ai][bj][m][n], 0, 0, 0); __builtin_amdgcn_s_setprio(0); } while (0)
#define PG8_WAIT_V(n) asm volatile("s_waitcnt vmcnt(" #n ")" ::: "memory")
#define PG8_WAIT_L(n) asm volatile("s_waitcnt lgkmcnt(" #n ")" ::: "memory")
#define PG8_BAR __builtin_amdgcn_s_barrier()
#define PG8_SCHED __builtin_amdgcn_sched_barrier(0)
    Unit cur, nxt; int ui = 0;
    if (!S.next(0, cur)) return;
    f32x4 acc[2][2][4][2];
#pragma unroll
    for (int a = 0; a < 2; ++a)
#pragma unroll
        for (int b = 0; b < 2; ++b)
#pragma unroll
            for (int m = 0; m < 4; ++m)
#pragma unroll
                for (int n = 0; n < 2; ++n) acc[a][b][m][n] = (f32x4){0.f, 0.f, 0.f, 0.f};
    bf16x8 At[4][2], B0[2][2], B1[2][2];
    const char* cA = (const char*)g.A + (size_t)cur.pm * tstep; const char* cB = (const char*)g.Bt + (size_t)cur.pn * tstep;
    S.a_ready(cur);
    if constexpr (SP2) {
        PG8_STAGE(PG8_SB(0, 0), cB, voffB); PG8_STAGE(PG8_SB(0, 1), cB + hstep, voffB); PG8_STAGE(PG8_SA(0, 0), cA, voffA); PG8_STAGE(PG8_SA(0, 1), cA + hstep, voffA);
        if (wr == 1) PG8_BAR;
        PG8_WAIT_V(2); PG8_BAR;
        PG8_STAGE(PG8_SB(1, 0), cB + kstep, voffB); PG8_STAGE(PG8_SA(1, 0), cA + kstep, voffA); PG8_STAGE(PG8_SB(1, 1), cB + hstep + kstep, voffB);
        PG8_WAIT_V(6); PG8_BAR;
    } else {
        PG8_STAGE(PG8_SB(0, 0), cB, voffB); PG8_STAGE(PG8_SA(0, 0), cA, voffA); PG8_STAGE(PG8_SB(0, 1), cB + hstep, voffB); PG8_STAGE(PG8_SA(0, 1), cA + hstep, voffA);
        if (wr == 1) PG8_BAR;
        PG8_WAIT_V(4); PG8_BAR;
        PG8_STAGE(PG8_SB(1, 0), cB + kstep, voffB); PG8_STAGE(PG8_SA(1, 0), cA + kstep, voffA); PG8_STAGE(PG8_SB(1, 1), cB + hstep + kstep, voffB);
        PG8_WAIT_V(6); PG8_BAR;
    }
    for (;;) {
        const bool has_next = S.next(ui + 1, nxt);
        const char* nA = has_next ? (const char*)g.A + (size_t)nxt.pm * tstep : cA; const char* nB = has_next ? (const char*)g.Bt + (size_t)nxt.pn * tstep : cB;
        for (int t = 0; t < nt; t += 2) {
            const bool last = (t == nt - 2);
            const char* a1 = cA + (size_t)(t + 1) * kstep;
            const char* a2 = last ? nA : cA + (size_t)(t + 2) * kstep; const char* b2 = last ? nB : cB + (size_t)(t + 2) * kstep;
            const char* a3 = a2 + kstep; const char* b3 = b2 + kstep;
            if (last && has_next) S.a_ready(nxt);
            if constexpr (SP2) {
            PG8_LDB(B0, 0, 0); PG8_LDB(B1, 0, 1); PG8_SCHED; PG8_LDA(At, 0, 0); PG8_STAGE(PG8_SA(1, 1), a1 + hstep, voffA);
            PG8_WAIT_V(8); PG8_WAIT_L(0); PG8_BAR; PG8_MMA(0, 0, At, B0); PG8_MMA(0, 1, At, B1); PG8_BAR; PG8_SCHED;
            PG8_LDA(At, 0, 1); PG8_STAGE(PG8_SB(0, 0), b2, voffB); PG8_STAGE(PG8_SB(0, 1), b2 + hstep, voffB); PG8_STAGE(PG8_SA(0, 0), a2, voffA);
            PG8_WAIT_V(8); PG8_WAIT_L(0); PG8_BAR; PG8_MMA(1, 0, At, B0); PG8_MMA(1, 1, At, B1); PG8_BAR; PG8_SCHED;
            PG8_LDB(B0, 1, 0); PG8_LDB(B1, 1, 1); PG8_SCHED; PG8_LDA(At, 1, 0); PG8_STAGE(PG8_SA(0, 1), a2 + hstep, voffA);
            PG8_WAIT_V(8); PG8_WAIT_L(0); PG8_BAR; PG8_MMA(0, 0, At, B0); PG8_MMA(0, 1, At, B1); PG8_BAR; PG8_SCHED;
            PG8_LDA(At, 1, 1); PG8_STAGE(PG8_SB(1, 0), b3, voffB); PG8_STAGE(PG8_SB(1, 1), b3 + hstep, voffB); PG8_STAGE(PG8_SA(1, 0), a3, voffA);
            PG8_WAIT_V(8); PG8_WAIT_L(0); PG8_BAR; PG8_MMA(1, 0, At, B0); PG8_MMA(1, 1, At, B1); PG8_BAR; PG8_SCHED;
            } else {
            PG8_LDB(B0, 0, 0); PG8_SCHED; PG8_LDA(At, 0, 0); PG8_STAGE(PG8_SA(1, 1), a1 + hstep, voffA);
            PG8_WAIT_L(8); PG8_BAR; PG8_WAIT_L(0); PG8_MMA(0, 0, At, B0); PG8_BAR; PG8_SCHED;
            PG8_LDB(B1, 0, 1); PG8_STAGE(PG8_SB(0, 0), b2, voffB);
            PG8_BAR; PG8_WAIT_L(0); PG8_MMA(0, 1, At, B1); PG8_BAR;
            PG8_LDA(At, 0, 1); PG8_STAGE(PG8_SA(0, 0), a2, voffA);
            PG8_BAR; PG8_WAIT_L(0); PG8_MMA(1, 0, At, B0); PG8_BAR; PG8_SCHED;
            PG8_STAGE(PG8_SB(0, 1), b2 + hstep, voffB);
            PG8_WAIT_V(6); PG8_BAR; PG8_MMA(1, 1, At, B1); PG8_BAR;
            PG8_LDB(B0, 1, 0); PG8_SCHED; PG8_LDA(At, 1, 0); PG8_STAGE(PG8_SA(0, 1), a2 + hstep, voffA);
            PG8_WAIT_L(8); PG8_BAR; PG8_WAIT_L(0); PG8_MMA(0, 0, At, B0); PG8_BAR; PG8_SCHED;
            PG8_LDB(B1, 1, 1); PG8_STAGE(PG8_SB(1, 0), b3, voffB);
            PG8_BAR; PG8_WAIT_L(0); PG8_MMA(0, 1, At, B1); PG8_BAR;
            PG8_LDA(At, 1, 1); PG8_STAGE(PG8_SA(1, 0), a3, voffA);
            PG8_BAR; PG8_WAIT_L(0); PG8_MMA(1, 0, At, B0); PG8_BAR; PG8_SCHED;
            PG8_STAGE(PG8_SB(1, 1), b3 + hstep, voffB);
            PG8_WAIT_V(6); PG8_BAR; PG8_MMA(1, 1, At, B1); PG8_BAR;
            }
        }
        if constexpr (ALIGN_EPI) { if (wr == 0) PG8_BAR; }
        if constexpr (!Epi::AFTER_DRAIN) { E(acc, cur, wr, wc, fr, fq); S.done(cur); }
        if (!has_next) break;
#pragma unroll
        for (int a = 0; a < 2; ++a)
#pragma unroll
            for (int b = 0; b < 2; ++b)
#pragma unroll
                for (int m = 0; m < 4; ++m)
#pragma unroll
                    for (int n = 0; n < 2; ++n) acc[a][b][m][n] = (f32x4){0.f, 0.f, 0.f, 0.f};
        cur = nxt; cA = nA; cB = nB; ++ui;
        if constexpr (ALIGN_EPI) { if (wr == 1) PG8_BAR; }
    }
    PG8_WAIT_V(0);
    if constexpr (!ALIGN_EPI) { if (wr == 0) PG8_BAR; }
    PG8_BAR;
#undef PG8_SA
#undef PG8_SB
#undef PG8_STAGE
#undef PG8_LDA
#undef PG8_LDB
#undef PG8_MMA
#undef PG8_WAIT_V
#undef PG8_WAIT_L
#undef PG8_BAR
#undef PG8_SCHED
}
}

constexpr int NWAVES = 8;
constexpr int D = 2048, SEQ = 4096, NBP = 2, NBS = 8, LSMP = 4;
constexpr int MPROMPT = NBP * SEQ;
constexpr int MV = MPROMPT + NBS * LSMP;
constexpr int MP = 8448;
constexpr int FF = 5632, NUP = 2 * FF;
constexpr int AW = 1280, AH = 10, ADK = 128;
constexpr int BW = 768, NGRP = 3, HPG = 4, HD = 64;
constexpr int IN0 = 7444, IN0P = 7680, PLD = 7424;
constexpr int QB_OFF = 5120;
constexpr int IN1 = 6144;
constexpr int NSEQ = 10, NMOD = 9 * D;
constexpr int PASTLEN = 16384;
constexpr float EPS = 1e-6f;
constexpr float B_SCALE = 0.125f;
__host__ __device__ __forceinline__ int swaW(int g) { return 128 << (2 * g); }
__host__ __device__ __forceinline__ int swaD(int g) { return 1 << (2 * g); }

constexpr size_t O_YP = 0, O_YS = O_YP + (size_t)MPROMPT * D, O_PS = O_YS + (size_t)NBS * LSMP * D, O_PCONV = O_PS + (size_t)NBP * AH * 128 * 128,
    O_PKV0 = O_PCONV + (size_t)NBP * 3 * 3840, O_PKV1 = O_PKV0 + (size_t)NBP * 128 * 512, O_PKV2 = O_PKV1 + (size_t)NBP * 512 * 512, O_PSC = O_PKV2 + (size_t)NBP * 2048 * 512,
    O_SS = O_PSC + (size_t)NBP * 2 * D, O_SCONV = O_SS + (size_t)NBS * AH * 128 * 128, O_SKV0 = O_SCONV + (size_t)NBS * 3 * 3840, O_SKV1 = O_SKV0 + (size_t)NBS * 128 * 512,
    O_SKV2 = O_SKV1 + (size_t)NBS * 512 * 512, O_SSC = O_SKV2 + (size_t)NBS * 2048 * 512, O_END = O_SSC + (size_t)NBS * 2 * D;
static_assert(O_END == 32399872, "output size");

constexpr size_t MiB = 1u << 20;
constexpr size_t WS_CTL = 0, CTL_ZERO_BYTES = 1 * MiB;
constexpr size_t WS_MOD = 1 * MiB;
constexpr size_t WS_G = 3 * MiB;
constexpr size_t WS_BETA = 4 * MiB;
constexpr size_t WS_LSE = 5 * MiB;
constexpr size_t WS_AB = 6 * MiB;
constexpr size_t WS_WUP = 8 * MiB;
constexpr size_t WUP_STRIDE = (size_t)NUP * D * 2;
constexpr size_t WS_WDN = WS_WUP + 4 * WUP_STRIDE;
constexpr size_t WDN_STRIDE = (size_t)D * FF * 2;
constexpr size_t WS_WIN0 = WS_WDN + 4 * WDN_STRIDE;
constexpr size_t WS_WOUT0 = WS_WIN0 + (size_t)IN0P * D * 2;
constexpr size_t WS_WIN1 = WS_WOUT0 + (size_t)D * D * 2;
constexpr size_t WS_WOUT1 = WS_WIN1 + (size_t)IN1 * D * 2;
constexpr size_t WS_X = WS_WOUT1 + (size_t)D * D * 2;
constexpr size_t WS_H = WS_X + (size_t)MP * D * 4;
constexpr size_t WS_ACT = WS_H + (size_t)MP * D * 2;
constexpr size_t WS_PROJ = WS_ACT + (size_t)MP * FF * 2;
constexpr size_t WS_MIX = WS_PROJ + (size_t)MP * PLD * 2;
constexpr size_t WS_QKVC = WS_MIX + (size_t)MP * D * 2;
constexpr size_t WS_OA = WS_QKVC + (size_t)MP * 3840 * 2;
constexpr size_t WS_OB = WS_OA + (size_t)MP * AW * 4;
constexpr size_t WS_END = WS_OB + (size_t)MP * BW * 4;
static_assert(WS_MOD + (size_t)2 * NSEQ * NMOD * 4 <= WS_G && WS_AB + (size_t)MP * 32 * 4 <= WS_WUP, "small buffers");
static_assert(WS_WUP % 256 == 0 && WS_X % 256 == 0 && WS_H % 256 == 0 && WS_ACT % 256 == 0 && WS_PROJ % 256 == 0 && WS_MIX % 256 == 0 && WS_QKVC % 256 == 0 && WS_OA % 256 == 0 && WS_OB % 256 == 0, "alignment");

constexpr int CW_TMO = 0, CW_CODE = 1;
constexpr int CW_BAR = 4096;

constexpr int RING_OFF = 0, RING_BYTES = 131072;
constexpr int LDSCTL_OFF = RING_BYTES, MISC_OFF = LDSCTL_OFF + 320;
constexpr int LDS_BYTES = 147456;
static_assert(MISC_OFF + 128 <= LDS_BYTES, "LDS map");

#define GAS __attribute__((address_space(1)))
#define LAS __attribute__((address_space(3)))
typedef unsigned short bf16;
typedef unsigned v4u __attribute__((ext_vector_type(4)));
typedef unsigned v2u __attribute__((ext_vector_type(2)));
typedef float f32x4 __attribute__((ext_vector_type(4)));
typedef float f32x2 __attribute__((ext_vector_type(2)));
typedef GAS unsigned gu32;
#define RLX_AGENT __ATOMIC_RELAXED, __HIP_MEMORY_SCOPE_AGENT
#define LDS_WAIT() asm volatile("s_waitcnt lgkmcnt(0)" ::: "memory")
#define VM_WAIT() asm volatile("s_waitcnt vmcnt(0)" ::: "memory")
__device__ __forceinline__ unsigned f2bf(float f) { unsigned u = __builtin_bit_cast(unsigned, f); return (u + 0x7fffu + ((u >> 16) & 1u)) >> 16; }
__device__ __forceinline__ unsigned pk2(float lo, float hi) { return f2bf(lo) | (f2bf(hi) << 16); }
__device__ __forceinline__ float bf_lo(unsigned w) { return __builtin_bit_cast(float, w << 16); }
__device__ __forceinline__ float bf_hi(unsigned w) { return __builtin_bit_cast(float, w & 0xffff0000u); }
__device__ __forceinline__ float bf2f(bf16 h) { return __builtin_bit_cast(float, (unsigned)h << 16); }

#define XB_TMO      128
#define XB_XCNT(j)  (256  + 64 * (j))
#define XB_XSUB(j)  (1280 + 64 * (j))
#define XB_XGEN(j)  (2304 + 64 * (j))
#define XB_TOP      3328
#define XB_TOPGEN   3392
#define XCD_BAR_WORDS 3456
#define XB_SPIN_CAP (1u << 18)

__device__ __forceinline__ unsigned xb_ld(unsigned* p)              { return __hip_atomic_load(p, __ATOMIC_RELAXED, __HIP_MEMORY_SCOPE_AGENT); }
__device__ __forceinline__ unsigned xb_add(unsigned* p, unsigned v) { return __hip_atomic_fetch_add(p, v, __ATOMIC_RELAXED, __HIP_MEMORY_SCOPE_AGENT); }
__device__ __forceinline__ unsigned xb_xcc_id() { return (unsigned)__builtin_amdgcn_s_getreg((3 << 11) | 20) & 0xFu; }
#define XB_SPIN(cond, bar) do { unsigned _sp = 0; while (cond) { __builtin_amdgcn_s_sleep(1); \
    if ((++_sp & 255u) == 0u) { if (xb_ld(&(bar)[XB_TMO])) break; if (_sp > XB_SPIN_CAP) { atomicAdd(&(bar)[XB_TMO], 1u); break; } } } } while (0)

struct XcdBarrier {
    unsigned* bar; unsigned x;
    volatile LAS unsigned* st;
};
__device__ __forceinline__ XcdBarrier xcd_barrier_post(unsigned* bar, volatile LAS unsigned* st) {
    XcdBarrier b; b.bar = bar; b.x = xb_xcc_id(); b.st = st;
    if (threadIdx.x == 0) (void)xb_add(&bar[XB_XCNT(b.x)], 1u);
    return b;
}
__device__ __forceinline__ void xcd_barrier_complete(unsigned* bar, unsigned x, unsigned& nloc, unsigned& nx) {
    const unsigned G = gridDim.x * gridDim.y * gridDim.z;
    unsigned sum, cnt, mine, sp = 0u;
    for (;;) {
        sum = 0u; cnt = 0u; mine = 0u;
#pragma unroll
        for (unsigned j = 0; j < 16; ++j) { const unsigned c = xb_ld(&bar[XB_XCNT(j)]); sum += c; cnt += (c > 0u) ? 1u : 0u; mine = (j == x) ? c : mine; }
        if (sum == G) break;
        __builtin_amdgcn_s_sleep(1);
        if ((++sp & 255u) == 0u) { if (xb_ld(&bar[XB_TMO])) break; if (sp > XB_SPIN_CAP) { atomicAdd(&bar[XB_TMO], 1u); break; } }
    }
    nloc = mine > 0u ? mine : 1u; nx = cnt > 0u ? cnt : 1u;
}
__device__ __forceinline__ void xcd_barrier(const XcdBarrier& b) {
    asm volatile("s_waitcnt vmcnt(0)" ::: "memory");
    __syncthreads();
    if (threadIdx.x == 0) {
        unsigned* bar = b.bar;
        __builtin_amdgcn_s_waitcnt(0);
        unsigned nloc = b.st[0], nx = b.st[1];
        if (nloc == 0u) { xcd_barrier_complete(bar, b.x, nloc, nx); b.st[0] = nloc; b.st[1] = nx; }
        const unsigned old = xb_add(&bar[XB_XSUB(b.x)], 1u);
        const unsigned gen = old / nloc;
        if (old + 1u == (gen + 1u) * nloc) {
            __builtin_amdgcn_fence(__ATOMIC_RELEASE, "agent");
            asm volatile("s_waitcnt vmcnt(0)" ::: "memory");
            const unsigned og = xb_add(&bar[XB_TOP], 1u);
            const unsigned tg = og / nx;
            if (og + 1u == (tg + 1u) * nx) xb_add(&bar[XB_TOPGEN], 1u);
            else XB_SPIN(xb_ld(&bar[XB_TOPGEN]) == tg, bar);
            __builtin_amdgcn_fence(__ATOMIC_ACQUIRE, "agent");
            xb_add(&bar[XB_XGEN(b.x)], 1u);
            asm volatile("s_waitcnt vmcnt(0)" ::: "memory");
        } else {
            XB_SPIN(xb_ld(&bar[XB_XGEN(b.x)]) == gen, bar);
            __builtin_amdgcn_fence(__ATOMIC_ACQUIRE, "agent");
            asm volatile("s_waitcnt vmcnt(0)" ::: "memory");
        }
    }
    __syncthreads();
}

struct Args { const float* in[27]; float* out; unsigned char* ws; int ph_lo, ph_hi; };
struct Frame {
    LAS unsigned char* lds;
    volatile LAS unsigned* MISC;
    gu32* ctl;
    int tid, lane, wave;
    int vcu, G;
    float* out;
    unsigned char* ws;
};

__device__ __forceinline__ float wave_sum(float v) {
#pragma unroll
    for (int o = 1; o < 64; o <<= 1) v += __shfl_xor(v, o);
    return v;
}
__device__ __forceinline__ float wave_max(float v) {
#pragma unroll
    for (int o = 1; o < 64; o <<= 1) v = fmaxf(v, __shfl_xor(v, o));
    return v;
}

__device__ __forceinline__ int src_col(int kind, int rr) {
    if (kind == 0) return rr;
    if (kind == 1) { const int t = rr >> 8, cc = rr & 255; return cc < 128 ? t * 128 + cc : FF + t * 128 + (cc - 128); }
    if (kind == 2) { if (rr < 5120) return rr; if (rr < 7424) return rr + 20; if (rr < 7444) return rr - 7424 + 5120; return -1; }
    if (rr < 2048) return rr;
    { const int q = rr - 2048, t = q >> 8, cc = q & 255; return cc < 128 ? 2048 + t * 128 + cc : 4096 + t * 128 + (cc - 128); }
}
__device__ __forceinline__ void p0_transpose_item(const float* W, int K, int N, bf16* WT, int kind, LAS float* scr, int item, int nblk, int lane) {
    const int kb = item / nblk, nb = item % nblk, k0 = 64 * kb, n0 = 32 * nb;
    const int sc = src_col(kind, n0 + (lane & 31));
#pragma unroll 8
    for (int i = 0; i < 32; ++i) { const int kk = 2 * i + (lane >> 5); scr[kk * 33 + (lane & 31)] = sc >= 0 ? W[(size_t)(k0 + kk) * N + sc] : 0.f; }
    LDS_WAIT(); asm volatile("" ::: "memory");
    const int c = lane & 7;
#pragma unroll
    for (int j = 0; j < 4; ++j) { const int n = (lane >> 3) + 8 * j; const LAS float* s = scr + (8 * c) * 33 + n;
        v4u o; o.x = pk2(s[0 * 33], s[1 * 33]); o.y = pk2(s[2 * 33], s[3 * 33]); o.z = pk2(s[4 * 33], s[5 * 33]); o.w = pk2(s[6 * 33], s[7 * 33]);
        *(GAS v4u*)(WT + (size_t)(n0 + n) * K + k0 + 8 * c) = o; }
    LDS_WAIT(); asm volatile("" ::: "memory");
}
__device__ __forceinline__ void p0_weights(Frame& F, const Args& args) {
    LAS float* scr = (LAS float*)(F.lds + RING_OFF + F.wave * 16384);
    const int gw = F.vcu * NWAVES + F.wave, NGW = F.G * NWAVES;
    constexpr int I_UP = (D / 64) * (NUP / 32), I_DN = (FF / 64) * (D / 32), I_IN0 = (D / 64) * (IN0P / 32), I_O = (D / 64) * (D / 32), I_IN1 = (D / 64) * (IN1 / 32);
    constexpr int NITEMS = 4 * I_UP + 4 * I_DN + I_IN0 + I_O + I_IN1 + I_O;
    for (int it = gw; it < NITEMS; it += NGW) {
        int r = it;
        if (r < 4 * I_UP) { const int w = r / I_UP; r -= w * I_UP;
            p0_transpose_item((args.in[16]) + (size_t)w * D * NUP, D, NUP, (bf16*)(F.ws + WS_WUP + w * WUP_STRIDE), 1, scr, r, NUP / 32, F.lane); continue; }
        r -= 4 * I_UP;
        if (r < 4 * I_DN) { const int w = r / I_DN; r -= w * I_DN;
            p0_transpose_item((args.in[17]) + (size_t)w * FF * D, FF, D, (bf16*)(F.ws + WS_WDN + w * WDN_STRIDE), 0, scr, r, D / 32, F.lane); continue; }
        r -= 4 * I_DN;
        if (r < I_IN0) { p0_transpose_item((args.in[18]), D, IN0, (bf16*)(F.ws + WS_WIN0), 2, scr, r, IN0P / 32, F.lane); continue; }
        r -= I_IN0;
        if (r < I_O) { p0_transpose_item((args.in[23]), D, D, (bf16*)(F.ws + WS_WOUT0), 0, scr, r, D / 32, F.lane); continue; }
        r -= I_O;
        if (r < I_IN1) { p0_transpose_item((args.in[24]), D, IN1, (bf16*)(F.ws + WS_WIN1), 3, scr, r, IN1 / 32, F.lane); continue; }
        r -= I_IN1;
        p0_transpose_item((args.in[26]), D, D, (bf16*)(F.ws + WS_WOUT1), 0, scr, r, D / 32, F.lane);
    }
}
__device__ __forceinline__ void p0_mod(Frame& F, const Args& args) {
    LAS float* SC = (LAS float*)(F.lds + RING_OFF);
    LAS float* RED = (LAS float*)(F.lds + RING_OFF + 81920);
    __syncthreads();
    for (int i = F.tid; i < NSEQ * D; i += NWAVES * 64) { const int s = i / D, k = i % D; const float c = s < NBP ? (args.in[2])[s * D + k] : (args.in[3])[(s - NBP) * D + k];
        SC[k * NSEQ + s] = c / (1.0f + __expf(-c)); }
    __syncthreads();
    for (int slab = F.vcu; slab < 256; slab += F.G) {
        const int l = slab >> 7, n0 = (slab & 127) * 144;
        float acc[NSEQ][4];
#pragma unroll
        for (int s = 0; s < NSEQ; ++s) { acc[s][0] = 0.f; acc[s][1] = 0.f; acc[s][2] = 0.f; acc[s][3] = 0.f; }
        if (F.lane < 36) {
            const float* wp = (args.in[10]) + ((size_t)l * D + F.wave * 256) * NMOD + n0 + 4 * F.lane;
            const LAS float* sp = SC + (F.wave * 256) * NSEQ;
#pragma unroll 8
            for (int k = 0; k < 256; ++k) { const f32x4 w = *(const f32x4*)(wp + (size_t)k * NMOD);
#pragma unroll
                for (int s = 0; s < NSEQ; ++s) { const float c = sp[k * NSEQ + s]; acc[s][0] += c * w[0]; acc[s][1] += c * w[1]; acc[s][2] += c * w[2]; acc[s][3] += c * w[3]; } }
#pragma unroll
            for (int s = 0; s < NSEQ; ++s)
#pragma unroll
                for (int j = 0; j < 4; ++j) RED[(F.wave * NSEQ + s) * 144 + 4 * F.lane + j] = acc[s][j];
        }
        __syncthreads();
        for (int i = F.tid; i < NSEQ * 144; i += NWAVES * 64) { const int s = i / 144, j = i % 144; float v = (args.in[11])[l * NMOD + n0 + j];
#pragma unroll
            for (int w = 0; w < 8; ++w) v += RED[(w * NSEQ + s) * 144 + j];
            ((float*)(F.ws + WS_MOD))[((size_t)l * NSEQ + s) * NMOD + n0 + j] = v; }
        __syncthreads();
    }
}

__device__ __forceinline__ void norm_phase(Frame& F, const Args& args, const float* gain, const float* shift, const float* scale, bool first) {
    const int gw = F.vcu * NWAVES + F.wave, NGW = F.G * NWAVES;
    for (int m = gw; m < MP; m += NGW) {
        GAS v4u* o16 = (GAS v4u*)(((bf16*)(F.ws + WS_H)) + (size_t)m * D);
        if (m >= MV) {
#pragma unroll
            for (int j = 0; j < 4; ++j) o16[64 * j + F.lane] = (v4u){0u, 0u, 0u, 0u};
            continue; }
        const float* src = first ? (m < MPROMPT ? (args.in[0]) + (size_t)m * D : (args.in[1]) + (size_t)(m - MPROMPT) * D) : ((float*)(F.ws + WS_X)) + (size_t)m * D;
        const int seq = pg8::seq_of_row(m);
        f32x4 v[4][2]; float ss = 0.f;
#pragma unroll
        for (int j = 0; j < 4; ++j)
#pragma unroll
            for (int h = 0; h < 2; ++h) { v[j][h] = *(const f32x4*)(src + 512 * j + 8 * F.lane + 4 * h); ss += (v[j][h].x * v[j][h].x + v[j][h].y * v[j][h].y) + (v[j][h].z * v[j][h].z + v[j][h].w * v[j][h].w); }
        if (first) {
#pragma unroll
            for (int j = 0; j < 4; ++j)
#pragma unroll
                for (int h = 0; h < 2; ++h) *(f32x4*)(((float*)(F.ws + WS_X)) + (size_t)m * D + 512 * j + 8 * F.lane + 4 * h) = v[j][h]; }
        const float rstd = 1.0f / sqrtf(wave_sum(ss) * (1.0f / D) + EPS);
        const float* shp = shift + (size_t)seq * NMOD; const float* scp = scale + (size_t)seq * NMOD;
#pragma unroll
        for (int j = 0; j < 4; ++j) { float r[8];
#pragma unroll
            for (int h = 0; h < 2; ++h) { const int e = 512 * j + 8 * F.lane + 4 * h; const f32x4 g = *(const f32x4*)(gain + e), sh = *(const f32x4*)(shp + e), sc = *(const f32x4*)(scp + e);
                const f32x4 y = (v[j][h] * rstd) * g * (sc + 1.0f) + sh; r[4 * h + 0] = y.x; r[4 * h + 1] = y.y; r[4 * h + 2] = y.z; r[4 * h + 3] = y.w; }
            v4u o; o.x = pk2(r[0], r[1]); o.y = pk2(r[2], r[3]); o.z = pk2(r[4], r[5]); o.w = pk2(r[6], r[7]);
            o16[64 * j + F.lane] = o; }
    }
}
__device__ __forceinline__ void final_norm_phase(Frame& F, const Args& args) {
    const int gw = F.vcu * NWAVES + F.wave, NGW = F.G * NWAVES;
    for (int m = gw; m < MV; m += NGW) {
        const float* src = ((float*)(F.ws + WS_X)) + (size_t)m * D; float* dst = F.out + O_YP + (size_t)m * D;
        f32x4 v[8]; float ss = 0.f;
#pragma unroll
        for (int j = 0; j < 8; ++j) { v[j] = *(const f32x4*)(src + 256 * j + 4 * F.lane); ss += (v[j].x * v[j].x + v[j].y * v[j].y) + (v[j].z * v[j].z + v[j].w * v[j].w); }
        const float rstd = 1.0f / sqrtf(wave_sum(ss) * (1.0f / D) + EPS);
#pragma unroll
        for (int j = 0; j < 8; ++j) { const f32x4 g = *(const f32x4*)((args.in[15]) + 256 * j + 4 * F.lane); *(f32x4*)(dst + 256 * j + 4 * F.lane) = (v[j] * rstd) * g; }
    }
}

__device__ __forceinline__ float softplus_f(float x) { return x > 20.f ? x : log1pf(__expf(x)); }
__device__ __forceinline__ void gdn_prep(Frame& F, const Args& args) {
    const int gw = F.vcu * NWAVES + F.wave, NGW = F.G * NWAVES;
    for (int id = gw; id < MV * AH; id += NGW) {
        const int m = id / AH, h = id % AH;
        const bool smp = m >= MPROMPT; const int t = smp ? ((m - MPROMPT) & 3) : (m & (SEQ - 1)); const int sb = smp ? ((m - MPROMPT) >> 2) : 0;
        float y[3][2];
#pragma unroll
        for (int part = 0; part < 3; ++part) {
            const int c = part * AW + h * ADK + 2 * F.lane;
            float a0 = 0.f, a1 = 0.f;
#pragma unroll
            for (int j = 0; j < 4; ++j) { const int tt = t - 3 + j; float x0, x1;
                if (tt >= 0) { const unsigned w = *(const unsigned*)(((bf16*)(F.ws + WS_PROJ)) + (size_t)(m - t + tt) * PLD + c); x0 = bf_lo(w); x1 = bf_hi(w); }
                else if (smp) { const f32x2 w = *(const f32x2*)((args.in[5]) + (size_t)(sb * 3 + (3 + tt)) * 3840 + c); x0 = w.x; x1 = w.y; }
                else { x0 = 0.f; x1 = 0.f; }
                const f32x2 cw = *(const f32x2*)((args.in[19]) + (size_t)j * 3840 + c); a0 += cw.x * x0; a1 += cw.y * x1; }
            y[part][0] = a0 / (1.0f + __expf(-a0)); y[part][1] = a1 / (1.0f + __expf(-a1));
        }
        const float sq = wave_sum(y[0][0] * y[0][0] + y[0][1] * y[0][1]), sk = wave_sum(y[1][0] * y[1][0] + y[1][1] * y[1][1]);
        const float rq = (1.0f / sqrtf(sq + EPS)) * 0.08838834764831845f, rk = 1.0f / sqrtf(sk + EPS);
        bf16* qrow = ((bf16*)(F.ws + WS_QKVC)) + (size_t)m * 3840 + h * ADK + 2 * F.lane;
        *(unsigned*)(qrow) = pk2(y[0][0] * rq, y[0][1] * rq); *(unsigned*)(qrow + AW) = pk2(y[1][0] * rk, y[1][1] * rk); *(unsigned*)(qrow + 2 * AW) = pk2(y[2][0], y[2][1]);
        if (F.lane == 0) { const float aa = ((float*)(F.ws + WS_AB))[(size_t)m * 32 + h], bb = ((float*)(F.ws + WS_AB))[(size_t)m * 32 + 10 + h];
            ((float*)(F.ws + WS_G))[(size_t)m * AH + h] = -__expf((args.in[20])[h]) * softplus_f(aa + (args.in[21])[h]); ((float*)(F.ws + WS_BETA))[(size_t)m * AH + h] = 1.0f / (1.0f + __expf(-bb)); }
    }
}
__device__ __forceinline__ void swa_prompt(Frame& F, const Args& args) {
    LAS unsigned* Ks = (LAS unsigned*)(F.lds + RING_OFF);
    LAS unsigned* Vs = (LAS unsigned*)(F.lds + RING_OFF + 25600);
    LAS float* Qs = (LAS float*)(F.lds + RING_OFF + 51200);
    LAS float* Ps = (LAS float*)(F.lds + RING_OFF + 51200 + 16384) + F.wave * 132;
    for (int u = F.vcu; u < 1536; u += F.G) {
        const int b = u / 768, r1 = u % 768, g = r1 >> 8, r2 = r1 & 255, hs = r2 >> 6, rb = r2 & 63;
        const int d = swaD(g), nqb = 64 / d, res = rb / nqb, qb = rb % nqb, s0 = qb * 64;
        const int hcol = (g * HPG + hs) * HD;
        __syncthreads();
        {
            const int ch = F.tid & 7;
#pragma unroll
            for (int p = 0; p < 3; ++p) { const int j = (F.tid >> 3) + 64 * p, s = s0 - 128 + j;
                v4u kv = (v4u){0u, 0u, 0u, 0u}, vv = kv;
                if (s >= 0) { const bf16* rowp = ((bf16*)(F.ws + WS_PROJ)) + (size_t)(b * SEQ + res + d * s) * PLD + QB_OFF + hcol + 8 * ch; kv = *(const v4u*)(rowp + BW); vv = *(const v4u*)(rowp + 2 * BW); }
                LAS unsigned* kd = Ks + j * 33 + 4 * ch; kd[0] = kv.x; kd[1] = kv.y; kd[2] = kv.z; kd[3] = kv.w;
                LAS unsigned* vd = Vs + j * 33 + 4 * ch; vd[0] = vv.x; vd[1] = vv.y; vd[2] = vv.z; vd[3] = vv.w; }
            { const int i = F.tid >> 3; const bf16* rowp = ((bf16*)(F.ws + WS_PROJ)) + (size_t)(b * SEQ + res + d * (s0 + i)) * PLD + QB_OFF + hcol + 8 * ch; const v4u qv = *(const v4u*)rowp;
              LAS float* qd = Qs + i * 64 + 8 * ch;
              qd[0] = bf_lo(qv.x) * B_SCALE; qd[1] = bf_hi(qv.x) * B_SCALE; qd[2] = bf_lo(qv.y) * B_SCALE; qd[3] = bf_hi(qv.y) * B_SCALE;
              qd[4] = bf_lo(qv.z) * B_SCALE; qd[5] = bf_hi(qv.z) * B_SCALE; qd[6] = bf_lo(qv.w) * B_SCALE; qd[7] = bf_hi(qv.w) * B_SCALE; }
        }
        __syncthreads();
        for (int qi = 0; qi < 8; ++qi) {
            const int i = F.wave * 8 + qi;
            const int j1 = i + F.lane, j2 = i + 64 + F.lane, j3 = i + 128;
            float a1 = 0.f, a2 = 0.f;
#pragma unroll 8
            for (int c = 0; c < 32; ++c) { const f32x2 q = *(const LAS f32x2*)(Qs + i * 64 + 2 * c); const unsigned k1 = Ks[j1 * 33 + c], k2 = Ks[j2 * 33 + c];
                a1 += q.x * bf_lo(k1) + q.y * bf_hi(k1); a2 += q.x * bf_lo(k2) + q.y * bf_hi(k2); }
            float a3; { const unsigned k3 = Ks[j3 * 33 + (F.lane >> 1)]; const float kk = (F.lane & 1) ? bf_hi(k3) : bf_lo(k3); a3 = wave_sum(Qs[i * 64 + F.lane] * kk); }
            if (s0 - 128 + j1 < 0) a1 = -INFINITY;
            if (s0 - 128 + j2 < 0) a2 = -INFINITY;
            const float mx = wave_max(fmaxf(fmaxf(a1, a2), a3));
            const float p1 = __expf(a1 - mx), p2 = __expf(a2 - mx), p3 = __expf(a3 - mx);
            const float den = wave_sum(p1 + p2) + p3, rden = 1.0f / den;
            Ps[F.lane] = p1 * rden; Ps[64 + F.lane] = p2 * rden; if (F.lane == 0) Ps[128] = p3 * rden;
            LDS_WAIT(); asm volatile("" ::: "memory");
            float o = 0.f;
            const LAS bf16* vcol = (const LAS bf16*)Vs + F.lane;
#pragma unroll 4
            for (int jj = 0; jj < 129; ++jj) o += Ps[jj] * bf2f(vcol[(i + jj) * 66]);
            const size_t mq = (size_t)(b * SEQ + res + d * (s0 + i));
            ((float*)(F.ws + WS_OB))[mq * BW + hcol + F.lane] = o;
            if (F.lane == 0) ((float*)(F.ws + WS_LSE))[mq * 12 + g * HPG + hs] = mx + __logf(den);
            LDS_WAIT(); asm volatile("" ::: "memory");
        }
    }
    __syncthreads();
}
__device__ __forceinline__ void swa_sample(Frame& F, const Args& args) {
    LAS float* Ps = (LAS float*)(F.lds + RING_OFF + 51200 + 16384) + F.wave * 132;
    const int gw = F.vcu * NWAVES + F.wave, NGW = F.G * NWAVES;
    for (int id = gw; id < NBS * LSMP * 12; id += NGW) {
        const int sb = id / 48, r1 = id % 48, t = r1 / 12, gh = r1 % 12, g = gh >> 2, hs = gh & 3;
        const int d = swaD(g), W = swaW(g);
        const float* cache = g == 0 ? (args.in[6]) : (g == 1 ? (args.in[7]) : (args.in[8]));
        const int hcol = gh * HD;
        const size_t mq = (size_t)(MPROMPT + sb * LSMP + t);
        const bf16* qrow = ((bf16*)(F.ws + WS_PROJ)) + mq * PLD + QB_OFF + hcol;
        float sc[3];
#pragma unroll
        for (int pass = 0; pass < 3; ++pass) {
            const int mm = pass * 64 + F.lane; float a = -INFINITY;
            if (mm <= 128) { const int p = t - d * mm; a = 0.f;
                if (p >= 0) { const bf16* kr = ((bf16*)(F.ws + WS_PROJ)) + (size_t)(MPROMPT + sb * LSMP + p) * PLD + QB_OFF + BW + hcol;
                    for (int e = 0; e < 64; e += 2) { const unsigned kw = *(const unsigned*)(kr + e), qw = *(const unsigned*)(qrow + e); a += bf_lo(qw) * bf_lo(kw) + bf_hi(qw) * bf_hi(kw); } }
                else { const float* kr = cache + ((size_t)(sb * W + (W + p)) * 2 + 0) * 256 + hs * HD;
                    for (int e = 0; e < 64; e += 2) { const f32x2 kw = *(const f32x2*)(kr + e); const unsigned qw = *(const unsigned*)(qrow + e); a += bf_lo(qw) * kw.x + bf_hi(qw) * kw.y; } }
                a *= B_SCALE; }
            sc[pass] = a;
        }
        const float mx = wave_max(fmaxf(fmaxf(sc[0], sc[1]), sc[2]));
        const float p0 = __expf(sc[0] - mx), p1 = __expf(sc[1] - mx), p2 = __expf(sc[2] - mx);
        const float den = wave_sum(p0 + p1 + p2), rden = 1.0f / den;
        Ps[F.lane] = p0 * rden; Ps[64 + F.lane] = p1 * rden; if (F.lane == 0) Ps[128] = p2 * rden;
        LDS_WAIT(); asm volatile("" ::: "memory");
        float o = 0.f;
        for (int mm = 0; mm <= 128; ++mm) { const int p = t - d * mm; float vv;
            if (p >= 0) vv = bf2f(((bf16*)(F.ws + WS_PROJ))[(size_t)(MPROMPT + sb * LSMP + p) * PLD + QB_OFF + 2 * BW + hcol + F.lane]);
            else vv = cache[((size_t)(sb * W + (W + p)) * 2 + 1) * 256 + hs * HD + F.lane];
            o += Ps[mm] * vv; }
        ((float*)(F.ws + WS_OB))[mq * BW + hcol + F.lane] = o;
        if (F.lane == 0) ((float*)(F.ws + WS_LSE))[mq * 12 + gh] = mx + __logf(den);
        LDS_WAIT(); asm volatile("" ::: "memory");
    }
}
__device__ __forceinline__ void mixer0_copies(Frame& F, const Args& args) {
    const long gt = (long)F.vcu * (NWAVES * 64) + F.tid, NGT = (long)F.G * NWAVES * 64;
    for (long i = gt; i < (long)(NBP + NBS) * 3 * 3840; i += NGT) { const int c = (int)(i % 3840), j = (int)((i / 3840) % 3), s = (int)(i / (3 * 3840));
        if (s < NBP) F.out[O_PCONV + (size_t)(s * 3 + j) * 3840 + c] = bf2f(((bf16*)(F.ws + WS_PROJ))[(size_t)(s * SEQ + SEQ - 3 + j) * PLD + c]);
        else { const int sb = s - NBP; F.out[O_SCONV + (size_t)(sb * 3 + j) * 3840 + c] = bf2f(((bf16*)(F.ws + WS_PROJ))[(size_t)(MPROMPT + sb * LSMP + 1 + j) * PLD + c]); } }
#pragma unroll
    for (int g = 0; g < 3; ++g) {
        const int W = g == 0 ? 128 : (g == 1 ? 512 : 2048);
        const size_t op = g == 0 ? O_PKV0 : (g == 1 ? O_PKV1 : O_PKV2), os = g == 0 ? O_SKV0 : (g == 1 ? O_SKV1 : O_SKV2);
        const float* cache = g == 0 ? (args.in[6]) : (g == 1 ? (args.in[7]) : (args.in[8]));
        const long np = (long)NBP * W * 128, ns = (long)NBS * W * 128;
        for (long i = gt; i < np + ns; i += NGT) {
            const bool smp = i >= np; const long q = smp ? i - np : i;
            const int e4 = (int)(q & 15), hs = (int)((q >> 4) & 3), kv = (int)((q >> 6) & 1), j = (int)((q >> 7) % W), s = (int)((q >> 7) / W);
            const int pcol = QB_OFF + (kv + 1) * BW + (g * HPG + hs) * HD + 4 * e4;
            f32x4 v;
            if (!smp) { const v2u w = *(const v2u*)(((bf16*)(F.ws + WS_PROJ)) + (size_t)(s * SEQ + SEQ - W + j) * PLD + pcol); v = (f32x4){bf_lo(w.x), bf_hi(w.x), bf_lo(w.y), bf_hi(w.y)};
                *(f32x4*)(F.out + op + (size_t)q * 4) = v; }
            else { if (j < W - LSMP) v = *(const f32x4*)(cache + (((size_t)(s * W + j + LSMP) * 2 + kv) * 4 + hs) * 64 + 4 * e4);
                else { const v2u w = *(const v2u*)(((bf16*)(F.ws + WS_PROJ)) + (size_t)(MPROMPT + s * LSMP + (j - (W - LSMP))) * PLD + pcol); v = (f32x4){bf_lo(w.x), bf_hi(w.x), bf_lo(w.y), bf_hi(w.y)}; }
                *(f32x4*)(F.out + os + (size_t)q * 4) = v; }
        }
    }
}
__device__ __forceinline__ void gdn_scan_naive(Frame& F, const Args& args) {
    LAS bf16* Kb = (LAS bf16*)(F.lds + RING_OFF);
    LAS bf16* Qb = (LAS bf16*)(F.lds + RING_OFF + 16384);
    LAS bf16* Vb = (LAS bf16*)(F.lds + RING_OFF + 32768);
    LAS float* gb = (LAS float*)(F.lds + RING_OFF + 40960);
    LAS float* bb = gb + 64;
    for (int task = F.vcu; task < 200; task += F.G) {
        const int chain = task >> 1, hf = task & 1;
        const bool smp = chain >= NBP * AH;
        const int seq = smp ? NBP + (chain - NBP * AH) / AH : chain / AH, h = smp ? (chain - NBP * AH) % AH : chain % AH;
        const int L = smp ? LSMP : SEQ, m0 = smp ? MPROMPT + (seq - NBP) * LSMP : seq * SEQ;
        const int vc = F.lane & 7, kg = F.lane >> 3, v0 = hf * 64 + F.wave * 8;
        float s[16];
        if (smp) {
#pragma unroll
            for (int i = 0; i < 16; ++i) s[i] = (args.in[4])[(((size_t)(seq - NBP) * AH + h) * 128 + kg * 16 + i) * 128 + v0 + vc];
        } else {
#pragma unroll
            for (int i = 0; i < 16; ++i) s[i] = 0.f;
        }
        for (int t0 = 0; t0 < L; t0 += 64) {
            const int nb = (L - t0) < 64 ? (L - t0) : 64;
            __syncthreads();
            for (int i = F.tid; i < nb * 16; i += NWAVES * 64) { const int tt = i >> 4, ch = i & 15; const bf16* rowp = ((bf16*)(F.ws + WS_QKVC)) + (size_t)(m0 + t0 + tt) * 3840 + h * ADK + 8 * ch;
                *(LAS v4u*)(Qb + tt * 128 + 8 * ch) = *(const v4u*)rowp; *(LAS v4u*)(Kb + tt * 128 + 8 * ch) = *(const v4u*)(rowp + AW);
                if (ch < 8) *(LAS v4u*)(Vb + tt * 64 + 8 * ch) = *(const v4u*)(rowp + 2 * AW + hf * 64); }
            if (F.tid < nb) { gb[F.tid] = __expf(((float*)(F.ws + WS_G))[(size_t)(m0 + t0 + F.tid) * AH + h]); bb[F.tid] = ((float*)(F.ws + WS_BETA))[(size_t)(m0 + t0 + F.tid) * AH + h]; }
            __syncthreads();
            for (int tt = 0; tt < nb; ++tt) {
                const float a = gb[tt], be = bb[tt];
                const v4u k0 = *(const LAS v4u*)(Kb + tt * 128 + kg * 16), k1 = *(const LAS v4u*)(Kb + tt * 128 + kg * 16 + 8);
                const v4u q0 = *(const LAS v4u*)(Qb + tt * 128 + kg * 16), q1 = *(const LAS v4u*)(Qb + tt * 128 + kg * 16 + 8);
                const float vv = bf2f(Vb[tt * 64 + F.wave * 8 + vc]);
                float kf[16], qf[16];
                kf[0] = bf_lo(k0.x); kf[1] = bf_hi(k0.x); kf[2] = bf_lo(k0.y); kf[3] = bf_hi(k0.y); kf[4] = bf_lo(k0.z); kf[5] = bf_hi(k0.z); kf[6] = bf_lo(k0.w); kf[7] = bf_hi(k0.w);
                kf[8] = bf_lo(k1.x); kf[9] = bf_hi(k1.x); kf[10] = bf_lo(k1.y); kf[11] = bf_hi(k1.y); kf[12] = bf_lo(k1.z); kf[13] = bf_hi(k1.z); kf[14] = bf_lo(k1.w); kf[15] = bf_hi(k1.w);
                qf[0] = bf_lo(q0.x); qf[1] = bf_hi(q0.x); qf[2] = bf_lo(q0.y); qf[3] = bf_hi(q0.y); qf[4] = bf_lo(q0.z); qf[5] = bf_hi(q0.z); qf[6] = bf_lo(q0.w); qf[7] = bf_hi(q0.w);
                qf[8] = bf_lo(q1.x); qf[9] = bf_hi(q1.x); qf[10] = bf_lo(q1.y); qf[11] = bf_hi(q1.y); qf[12] = bf_lo(q1.z); qf[13] = bf_hi(q1.z); qf[14] = bf_lo(q1.w); qf[15] = bf_hi(q1.w);
                float part = 0.f;
#pragma unroll
                for (int i = 0; i < 16; ++i) { s[i] *= a; part += kf[i] * s[i]; }
                part += __shfl_xor(part, 8); part += __shfl_xor(part, 16); part += __shfl_xor(part, 32);
                const float dl = be * (vv - part);
                float op = 0.f;
#pragma unroll
                for (int i = 0; i < 16; ++i) { s[i] += kf[i] * dl; op += qf[i] * s[i]; }
                op += __shfl_xor(op, 8); op += __shfl_xor(op, 16); op += __shfl_xor(op, 32);
                if (kg == 0) ((float*)(F.ws + WS_OA))[(size_t)(m0 + t0 + tt) * AW + h * ADK + v0 + vc] = op;
            }
        }
        float* so = F.out + (smp ? O_SS + ((size_t)(seq - NBP) * AH + h) * 16384 : O_PS + ((size_t)seq * AH + h) * 16384);
#pragma unroll
        for (int i = 0; i < 16; ++i) so[(size_t)(kg * 16 + i) * 128 + v0 + vc] = s[i];
    }
    __syncthreads();
}
__device__ __forceinline__ void mixer0_gate(Frame& F, const Args& args) {
    const int gw = F.vcu * NWAVES + F.wave, NGW = F.G * NWAVES;
    const f32x2 on = *(const f32x2*)((args.in[22]) + 2 * F.lane);
    for (int m = gw; m < MV; m += NGW) {
        bf16* mrow = ((bf16*)(F.ws + WS_MIX)) + (size_t)m * D;
#pragma unroll 2
        for (int h = 0; h < AH; ++h) { const f32x2 o = *(const f32x2*)(((float*)(F.ws + WS_OA)) + (size_t)m * AW + h * ADK + 2 * F.lane);
            const float rs = 1.0f / sqrtf(wave_sum(o.x * o.x + o.y * o.y) * (1.0f / 128.0f) + EPS);
            const unsigned zw = *(const unsigned*)(((bf16*)(F.ws + WS_PROJ)) + (size_t)m * PLD + 3840 + h * ADK + 2 * F.lane); const float z0 = bf_lo(zw), z1 = bf_hi(zw);
            *(unsigned*)(mrow + h * ADK + 2 * F.lane) = pk2(o.x * rs * on.x * (z0 / (1.0f + __expf(-z0))), o.y * rs * on.y * (z1 / (1.0f + __expf(-z1)))); }
#pragma unroll
        for (int hs = 0; hs < HPG; ++hs) { const float l0 = ((float*)(F.ws + WS_LSE))[(size_t)m * 12 + hs], l1 = ((float*)(F.ws + WS_LSE))[(size_t)m * 12 + 4 + hs], l2 = ((float*)(F.ws + WS_LSE))[(size_t)m * 12 + 8 + hs];
            const float mx = fmaxf(fmaxf(l0, l1), l2), e0 = __expf(l0 - mx), e1 = __expf(l1 - mx), e2 = __expf(l2 - mx), rs = 1.0f / (e0 + e1 + e2);
            const float al[3] = {e0 * rs, e1 * rs, e2 * rs};
#pragma unroll
            for (int g = 0; g < 3; ++g) { const int col = (g * HPG + hs) * HD + F.lane; mrow[AW + col] = (bf16)f2bf(((float*)(F.ws + WS_OB))[(size_t)m * BW + col] * al[g]); } }
    }
}
__device__ __forceinline__ void mixer1_conv(Frame& F, const Args& args) {
    const bf16* BG = ((bf16*)(F.ws + WS_PROJ)); const bf16* P = ((bf16*)(F.ws + WS_PROJ)) + (size_t)MP * D;
    const long gt = (long)F.vcu * (NWAVES * 64) + F.tid, NGT = (long)F.G * NWAVES * 64;
    for (long i = gt; i < (long)MV * 256; i += NGT) {
        const int m = (int)(i >> 8), c = (int)(i & 255) * 8;
        const bool smp = m >= MPROMPT; const int t = smp ? ((m - MPROMPT) & 3) : (m & (SEQ - 1)); const int sb = smp ? ((m - MPROMPT) >> 2) : 0;
        float y[8];
#pragma unroll
        for (int e = 0; e < 8; ++e) y[e] = 0.f;
#pragma unroll
        for (int j = 0; j < 3; ++j) { const int tt = t - 2 + j; float pv[8];
            if (tt >= 0) { const v4u w = *(const v4u*)(P + (size_t)(m - t + tt) * D + c); pv[0] = bf_lo(w.x); pv[1] = bf_hi(w.x); pv[2] = bf_lo(w.y); pv[3] = bf_hi(w.y); pv[4] = bf_lo(w.z); pv[5] = bf_hi(w.z); pv[6] = bf_lo(w.w); pv[7] = bf_hi(w.w); }
            else if (smp) { const float* sp = (args.in[9]) + (size_t)(sb * 2 + (2 + tt)) * D + c; const f32x4 a = *(const f32x4*)sp, b = *(const f32x4*)(sp + 4);
                pv[0] = a.x; pv[1] = a.y; pv[2] = a.z; pv[3] = a.w; pv[4] = b.x; pv[5] = b.y; pv[6] = b.z; pv[7] = b.w; }
            else {
#pragma unroll
                for (int e = 0; e < 8; ++e) pv[e] = 0.f; }
            const f32x4 w0 = *(const f32x4*)((args.in[25]) + (size_t)j * D + c), w1 = *(const f32x4*)((args.in[25]) + (size_t)j * D + c + 4);
            y[0] += w0.x * pv[0]; y[1] += w0.y * pv[1]; y[2] += w0.z * pv[2]; y[3] += w0.w * pv[3]; y[4] += w1.x * pv[4]; y[5] += w1.y * pv[5]; y[6] += w1.z * pv[6]; y[7] += w1.w * pv[7]; }
        const v4u bw = *(const v4u*)(BG + (size_t)m * D + c);
        v4u o; o.x = pk2(bf_lo(bw.x) * y[0], bf_hi(bw.x) * y[1]); o.y = pk2(bf_lo(bw.y) * y[2], bf_hi(bw.y) * y[3]); o.z = pk2(bf_lo(bw.z) * y[4], bf_hi(bw.z) * y[5]); o.w = pk2(bf_lo(bw.w) * y[6], bf_hi(bw.w) * y[7]);
        *(v4u*)(((bf16*)(F.ws + WS_MIX)) + (size_t)m * D + c) = o;
    }
    for (long i = gt; i < (long)(NBP + NBS) * 2 * D; i += NGT) { const int c = (int)(i % D), j = (int)((i / D) % 2), s = (int)(i / (2 * D));
        if (s < NBP) F.out[O_PSC + (size_t)(s * 2 + j) * D + c] = bf2f(P[(size_t)(s * SEQ + SEQ - 2 + j) * D + c]);
        else { const int sb = s - NBP; F.out[O_SSC + (size_t)(sb * 2 + j) * D + c] = bf2f(P[(size_t)(MPROMPT + sb * LSMP + 2 + j) * D + c]); } }
}

#define IN_PH() (lo <= pid && pid < hi)
#define SEAM() do { if (MK_N_LAUNCHES == 1 && lo <= pid && pid + 1 < hi) xcd_barrier(bar); ++pid; } while (0)
template <int L, int SUB>
__device__ __forceinline__ void sublayer(Frame& F, const Args& args, const XcdBarrier& bar, int& pid, const int lo, const int hi) {
    unsigned char* ws = F.ws;
    const float* modl = (const float*)(ws + WS_MOD) + (size_t)L * NSEQ * NMOD;
    if (IN_PH()) { const float* gain = args.in[SUB == 0 ? 12 : (SUB == 1 ? 13 : 14)] + (size_t)L * D;
        norm_phase(F, args, gain, modl + (size_t)(3 * SUB) * D, modl + (size_t)(3 * SUB + 1) * D, L == 0 && SUB == 0); }
    SEAM();
    if constexpr (SUB != 1) {
        constexpr int f = SUB >> 1;
        if (IN_PH()) { pg8::Gemm g{(const pg8::bf16_t*)(ws + WS_H), (const pg8::bf16_t*)(ws + WS_WUP + (size_t)(L * 2 + f) * WUP_STRIDE), MP, NUP, D}; pg8::StaticOrder S; S.init(MP, NUP, F.G, (int)blockIdx.x);
            pg8::EpiSwiglu E{(pg8::bf16_t*)(ws + WS_ACT), FF};
            pg8::gemm_phase<pg8::EpiSwiglu, pg8::StaticOrder, true, true>(F.lds + RING_OFF, g, S, E); }
        SEAM();
        if (IN_PH()) { pg8::Gemm g{(const pg8::bf16_t*)(ws + WS_ACT), (const pg8::bf16_t*)(ws + WS_WDN + (size_t)(L * 2 + f) * WDN_STRIDE), MP, D, FF}; pg8::StaticOrder S; S.init(MP, D, F.G, (int)blockIdx.x);
            pg8::EpiResid E{(float*)(ws + WS_X), modl + (size_t)(3 * SUB + 2) * D, 0.5f};
            pg8::gemm_phase<pg8::EpiResid, pg8::StaticOrder, true, true>(F.lds + RING_OFF, g, S, E); }
        SEAM();
    } else {
        if constexpr (L == 0) {
            if (IN_PH()) { pg8::Gemm g{(const pg8::bf16_t*)(ws + WS_H), (const pg8::bf16_t*)(ws + WS_WIN0), MP, IN0P, D}; pg8::StaticOrder S; S.init(MP, IN0P, F.G, (int)blockIdx.x);
                pg8::EpiIn0 E{(pg8::bf16_t*)(ws + WS_PROJ), PLD, (float*)(ws + WS_AB)};
                pg8::gemm_phase<pg8::EpiIn0, pg8::StaticOrder, true, true>(F.lds + RING_OFF, g, S, E); }
            SEAM();
            if (IN_PH()) { gdn_prep(F, args); swa_prompt(F, args); swa_sample(F, args); mixer0_copies(F, args); }
            SEAM();
            if (IN_PH()) { gdn_scan_naive(F, args); }
            SEAM();
            if (IN_PH()) { mixer0_gate(F, args); }
            SEAM();
        } else {
            if (IN_PH()) { pg8::Gemm g{(const pg8::bf16_t*)(ws + WS_H), (const pg8::bf16_t*)(ws + WS_WIN1), MP, IN1, D}; pg8::StaticOrder S; S.init(MP, IN1, F.G, (int)blockIdx.x);
                pg8::EpiIn1 E{(pg8::bf16_t*)(ws + WS_PROJ), (pg8::bf16_t*)(ws + WS_PROJ) + (size_t)MP * D};
                pg8::gemm_phase<pg8::EpiIn1, pg8::StaticOrder, true, true>(F.lds + RING_OFF, g, S, E); }
            SEAM();
            if (IN_PH()) { mixer1_conv(F, args); }
            SEAM();
        }
        if (IN_PH()) { pg8::Gemm g{(const pg8::bf16_t*)(ws + WS_MIX), (const pg8::bf16_t*)(ws + (L == 0 ? WS_WOUT0 : WS_WOUT1)), MP, D, D}; pg8::StaticOrder S; S.init(MP, D, F.G, (int)blockIdx.x);
            pg8::EpiResid E{(float*)(ws + WS_X), modl + (size_t)(3 * SUB + 2) * D, 1.0f};
            pg8::gemm_phase<pg8::EpiResid, pg8::StaticOrder, true, true>(F.lds + RING_OFF, g, S, E); }
        SEAM();
    }
}

__global__ void __launch_bounds__(NWAVES * 64, 2) fwd(Args args) {
    extern __shared__ __attribute__((aligned(16))) unsigned char lds[];
    Frame F;
    F.lds = (LAS unsigned char*)lds;
    F.MISC = (volatile LAS unsigned*)(F.lds + MISC_OFF);
    F.tid = threadIdx.x; F.lane = F.tid & 63; F.wave = __builtin_amdgcn_readfirstlane(F.tid >> 6);
    F.G = gridDim.x; { const int bx = blockIdx.x; F.vcu = (F.G % 8 == 0) ? (bx % 8) * (F.G / 8) + bx / 8 : bx; }
    F.ws = args.ws; F.out = args.out;
    F.ctl = (gu32*)(args.ws + WS_CTL);
    for (int u = F.tid; u < (LDS_BYTES - LDSCTL_OFF) / 4; u += NWAVES * 64) ((LAS unsigned*)(F.lds + LDSCTL_OFF))[u] = 0u;
    __syncthreads();
    XcdBarrier bar; bar.bar = (unsigned*)(F.ctl + CW_BAR); bar.x = 0; bar.st = nullptr;
    if (MK_N_LAUNCHES == 1) bar = xcd_barrier_post((unsigned*)(F.ctl + CW_BAR), F.MISC + 8);

    const int lo = args.ph_lo, hi = args.ph_hi;
    int pid = 0;
    if (IN_PH()) { p0_weights(F, args); p0_mod(F, args); }
    SEAM();
    sublayer<0, 0>(F, args, bar, pid, lo, hi);
    sublayer<0, 1>(F, args, bar, pid, lo, hi);
    sublayer<0, 2>(F, args, bar, pid, lo, hi);
    sublayer<1, 0>(F, args, bar, pid, lo, hi);
    sublayer<1, 1>(F, args, bar, pid, lo, hi);
    sublayer<1, 2>(F, args, bar, pid, lo, hi);
    if (IN_PH()) { final_norm_phase(F, args); }
}
#undef IN_PH
#undef SEAM
constexpr int N_PHASES = 1 + (3 + 3 + 3 + 3) + (3 + 3 + 3 + 1) + 1;

extern "C" void kernel_launch(void* const* d_in, const int* in_sizes, int n_in, void* d_out, int out_size, void* d_ws, size_t ws_size, hipStream_t stream) {
    static int grid = 0;
    if (grid == 0) {
        if (n_in != 27 || out_size != (int)O_END || ws_size < WS_END) { fprintf(stderr, "kernel_launch: expected 27 inputs, %zu outputs, >= %zu B workspace; got %d, %d, %zu\n", (size_t)O_END, (size_t)WS_END, n_in, out_size, ws_size); grid = -1; return; }
        int dev = 0, cus = 0, per_cu = 0;
        if (hipGetDevice(&dev) != hipSuccess || hipDeviceGetAttribute(&cus, hipDeviceAttributeMultiprocessorCount, dev) != hipSuccess) { fprintf(stderr, "kernel_launch: device query failed\n"); grid = -1; return; }
        if (hipFuncSetAttribute((const void*)fwd, hipFuncAttributeMaxDynamicSharedMemorySize, LDS_BYTES) != hipSuccess) { fprintf(stderr, "kernel_launch: hipFuncSetAttribute failed\n"); grid = -1; return; }
        if (hipOccupancyMaxActiveBlocksPerMultiprocessor(&per_cu, (const void*)fwd, NWAVES * 64, LDS_BYTES) != hipSuccess || per_cu < 1)
            fprintf(stderr, "kernel_launch: note: occupancy query reports %d workgroups per CU\n", per_cu);
        (void)hipGetLastError();
        grid = cus;
    }
    if (grid < 0) return;
    if (hipMemsetAsync((char*)d_ws + WS_CTL, 0, CTL_ZERO_BYTES, stream) != hipSuccess) { fprintf(stderr, "kernel_launch: memset failed\n"); return; }
    Args a{};
    for (int i = 0; i < 27; ++i) a.in[i] = (const float*)d_in[i];
    a.out = (float*)d_out; a.ws = (unsigned char*)d_ws;
    if (MK_N_LAUNCHES == 1) {
        a.ph_lo = 0; a.ph_hi = N_PHASES;
        hipLaunchKernelGGL(fwd, dim3(grid), dim3(NWAVES * 64), LDS_BYTES, stream, a);
    } else {
        for (int p = 0; p < N_PHASES; ++p) { a.ph_lo = p; a.ph_hi = p + 1; hipLaunchKernelGGL(fwd, dim3(grid), dim3(NWAVES * 64), LDS_BYTES, stream, a); }
    }
    const hipError_t le = hipPeekAtLastError();
    if (le != hipSuccess) fprintf(stderr, "kernel_launch: launch failed: %s\n", hipGetErrorName(le));
}
```

```cpp
#include <hip/hip_runtime.h>
#include <cstdio>
#include <cstdint>

#ifndef MK_N_LAUNCHES
#define MK_N_LAUNCHES 1
#endif

namespace pg8 {
#define PG8_LAS __attribute__((address_space(3)))
typedef unsigned short bf16_t;
typedef short bf16x8 __attribute__((ext_vector_type(8)));
typedef float f32x4 __attribute__((ext_vector_type(4)));
typedef unsigned u32x4 __attribute__((ext_vector_type(4)));
constexpr int BM = 256, BK = 64, HALF = 128, HTB = HALF * BK * 2, STAGE_BYTES = 8 * HTB, NXCD = 8, WGM = 8;

__host__ __device__ __forceinline__ int lds_byte(int r, int c) { const int st = (r >> 4) * 2 + (c >> 5), rr = r & 15, cc = c & 31, ob = rr * 64 + cc * 2; return st * 1024 + (ob ^ (((ob >> 9) & 1) << 5)); }
__host__ __device__ __forceinline__ void stage_rc(int b, int& R, int& C) { const int st = b / 1024, sb = b % 1024, swz = sb ^ (((sb >> 9) & 1) << 5); R = (st >> 1) * 16 + swz / 64; C = (st & 1) * 32 + (swz % 64) / 2; }
__host__ __device__ __forceinline__ int perm32(int rho) { const int n = rho >> 4, i = rho & 15; return 8 * (i >> 2) + 4 * n + (i & 3); }

struct Unit { int pm, pn; };
struct Gemm { const bf16_t* A; const bf16_t* Bt; int M, N, K; };

struct StaticOrder {
    int nM, nN, nwg, G, c;
    __host__ __device__ void init(int M, int N, int G_, int c_) { nM = M / BM; nN = N / BM; nwg = nM * nN; G = G_; c = c_; }
    __host__ __device__ bool next(int i, Unit& u) const {
        const long L = (long)i * G + c; if (L >= nwg) return false;
        int wgid = (int)L; { const int q = nwg / NXCD, r = nwg % NXCD, xcd = wgid % NXCD, off = wgid / NXCD; wgid = (xcd < r ? xcd * (q + 1) : r * (q + 1) + (xcd - r) * q) + off; }
        const int nig = WGM * nN, gid = wgid / nig, fm = gid * WGM, gsz = (nM - fm) < WGM ? (nM - fm) : WGM;
        u.pm = fm + ((wgid % nig) % gsz); u.pn = (wgid % nig) / gsz; return true;
    }
    __device__ __forceinline__ void a_ready(const Unit&) const {}
    __device__ __forceinline__ void done(const Unit&) const {}
};

__device__ __forceinline__ unsigned cvt_pk_bf16(float lo, float hi) { unsigned r; asm volatile("v_cvt_pk_bf16_f32 %0, %1, %2" : "=v"(r) : "v"(lo), "v"(hi)); return r; }
__device__ __forceinline__ float silu_f(float x) { return x * __builtin_amdgcn_rcpf(1.0f + __expf(-x)); }

constexpr int E_MV = 8224, E_MPROMPT = 8192, E_D = 2048, E_NMOD = 18432;
__device__ __forceinline__ int seq_of_row(int r) { return r < E_MPROMPT ? (r >> 12) : 2 + ((r - E_MPROMPT) >> 2); }

struct EpiSwiglu {
    static constexpr bool PERM = true, AFTER_DRAIN = false;
    bf16_t* O; int ldc;
    __device__ __forceinline__ void operator()(const f32x4 (&acc)[2][2][4][2], const Unit& u, int wr, int wc, int fr, int fq) const {
        const int row0 = u.pm * BM + wr * 64 + fr, col0 = u.pn * HALF + wc * 32 + 8 * fq;
#pragma unroll
        for (int ai = 0; ai < 2; ++ai)
#pragma unroll
            for (int m = 0; m < 4; ++m) { bf16_t* rowp = O + (size_t)(row0 + ai * HALF + m * 16) * ldc + col0;
                const f32x4 g0 = acc[ai][0][m][0], g1 = acc[ai][0][m][1], u0 = acc[ai][1][m][0], u1 = acc[ai][1][m][1];
                u32x4 w; w.x = cvt_pk_bf16(silu_f(g0[0]) * u0[0], silu_f(g0[1]) * u0[1]); w.y = cvt_pk_bf16(silu_f(g0[2]) * u0[2], silu_f(g0[3]) * u0[3]);
                w.z = cvt_pk_bf16(silu_f(g1[0]) * u1[0], silu_f(g1[1]) * u1[1]); w.w = cvt_pk_bf16(silu_f(g1[2]) * u1[2], silu_f(g1[3]) * u1[3]);
                *(u32x4*)rowp = w; }
    }
};
struct EpiResid {
    static constexpr bool PERM = false, AFTER_DRAIN = false;
    float* X; const float* gate; float scale;
    __device__ __forceinline__ void operator()(const f32x4 (&acc)[2][2][4][2], const Unit& u, int wr, int wc, int fr, int fq) const {
        const int col0 = u.pn * BM + wc * 32 + 4 * fq;
#pragma unroll
        for (int ai = 0; ai < 2; ++ai)
#pragma unroll
            for (int m = 0; m < 4; ++m) { const int r = u.pm * BM + ai * HALF + wr * 64 + m * 16 + fr;
                if (r < E_MV) { const float* gp = gate + (size_t)seq_of_row(r) * E_NMOD + col0; float* xp = X + (size_t)r * E_D + col0;
#pragma unroll
                    for (int bj = 0; bj < 2; ++bj)
#pragma unroll
                        for (int n = 0; n < 2; ++n) { const f32x4 gv = *(const f32x4*)(gp + bj * HALF + n * 16); f32x4 xv = *(const f32x4*)(xp + bj * HALF + n * 16);
                            xv = xv + (gv * scale) * acc[ai][bj][m][n]; *(f32x4*)(xp + bj * HALF + n * 16) = xv; } }
                if (m & 1) asm volatile("" ::: "memory"); }
    }
};
struct EpiIn0 {
    static constexpr bool PERM = true, AFTER_DRAIN = false;
    bf16_t* O; int ldc; float* AB;
    __device__ __forceinline__ void operator()(const f32x4 (&acc)[2][2][4][2], const Unit& u, int wr, int wc, int fr, int fq) const {
        const int row0 = u.pm * BM + wr * 64 + fr;
        if (u.pn < 29) { const int col0 = u.pn * BM + wc * 32 + 8 * fq;
#pragma unroll
            for (int ai = 0; ai < 2; ++ai)
#pragma unroll
                for (int m = 0; m < 4; ++m) { bf16_t* rowp = O + (size_t)(row0 + ai * HALF + m * 16) * ldc + col0;
#pragma unroll
                    for (int bj = 0; bj < 2; ++bj) { const f32x4 v0 = acc[ai][bj][m][0], v1 = acc[ai][bj][m][1];
                        u32x4 w; w.x = cvt_pk_bf16(v0[0], v0[1]); w.y = cvt_pk_bf16(v0[2], v0[3]); w.z = cvt_pk_bf16(v1[0], v1[1]); w.w = cvt_pk_bf16(v1[2], v1[3]);
                        *(u32x4*)(rowp + bj * HALF) = w; } }
        } else if (wc == 0) {
#pragma unroll
            for (int ai = 0; ai < 2; ++ai)
#pragma unroll
                for (int m = 0; m < 4; ++m) { float* rowp = AB + (size_t)(row0 + ai * HALF + m * 16) * 32 + 8 * fq;
                    *(f32x4*)rowp = acc[ai][0][m][0]; *(f32x4*)(rowp + 4) = acc[ai][0][m][1]; }
        }
    }
};
struct EpiIn1 {
    static constexpr bool PERM = true, AFTER_DRAIN = false;
    bf16_t* BG; bf16_t* P;
    __device__ __forceinline__ void operator()(const f32x4 (&acc)[2][2][4][2], const Unit& u, int wr, int wc, int fr, int fq) const {
        const int row0 = u.pm * BM + wr * 64 + fr;
        if (u.pn < 8) { const int col0 = u.pn * BM + wc * 32 + 8 * fq;
#pragma unroll
            for (int ai = 0; ai < 2; ++ai)
#pragma unroll
                for (int m = 0; m < 4; ++m) { bf16_t* rowp = BG + (size_t)(row0 + ai * HALF + m * 16) * E_D + col0;
#pragma unroll
                    for (int bj = 0; bj < 2; ++bj) { const f32x4 v0 = acc[ai][bj][m][0], v1 = acc[ai][bj][m][1];
                        u32x4 w; w.x = cvt_pk_bf16(v0[0], v0[1]); w.y = cvt_pk_bf16(v0[2], v0[3]); w.z = cvt_pk_bf16(v1[0], v1[1]); w.w = cvt_pk_bf16(v1[2], v1[3]);
                        *(u32x4*)(rowp + bj * HALF) = w; } }
        } else { const int col0 = (u.pn - 8) * HALF + wc * 32 + 8 * fq;
#pragma unroll
            for (int ai = 0; ai < 2; ++ai)
#pragma unroll
                for (int m = 0; m < 4; ++m) { bf16_t* rowp = P + (size_t)(row0 + ai * HALF + m * 16) * E_D + col0;
                    const f32x4 a0 = acc[ai][0][m][0], a1 = acc[ai][0][m][1], b0 = acc[ai][1][m][0], b1 = acc[ai][1][m][1];
                    u32x4 w; w.x = cvt_pk_bf16(a0[0] * b0[0], a0[1] * b0[1]); w.y = cvt_pk_bf16(a0[2] * b0[2], a0[3] * b0[3]);
                    w.z = cvt_pk_bf16(a1[0] * b1[0], a1[1] * b1[1]); w.w = cvt_pk_bf16(a1[2] * b1[2], a1[3] * b1[3]);
                    *(u32x4*)rowp = w; }
        }
    }
};

template <class Epi, class Sched, bool ALIGN_EPI = false, bool SP2 = false>
__device__ __forceinline__ void gemm_phase(PG8_LAS unsigned char* lds, const Gemm g, const Sched& S, const Epi& E) {
    const int tid = threadIdx.x, wid = __builtin_amdgcn_readfirstlane(tid >> 6), lane = tid & 63, wr = wid >> 2, wc = wid & 3, fr = lane & 15, fq = lane >> 4;
    const int K = g.K, nt = K / BK;
    unsigned voffA[2], voffB[2];
#pragma unroll
    for (int i = 0; i < 2; ++i) { int R, C; stage_rc(tid * 16 + i * 8192, R, C); const int Rb = Epi::PERM ? ((R & ~31) + perm32(R & 31)) : R;
        voffA[i] = (unsigned)(R * K + C) * 2u; voffB[i] = (unsigned)(Rb * K + C) * 2u; }
    const size_t kstep = (size_t)(BK * 2);
    const size_t hstep = (size_t)HALF * K * 2;
    const size_t tstep = 2 * hstep;
    const unsigned ldsw = (unsigned)wid * 1024u;
    const int aoff = lds_byte(wr * 64 + fr, fq * 8), boff = lds_byte(wc * 32 + fr, fq * 8);
#define PG8_SA(b, h) (((b) * 2 + (h)) * HTB)
#define PG8_SB(b, h) ((4 + (b) * 2 + (h)) * HTB)
#define PG8_STAGE(bufoff, gbase, voff) do { _Pragma("unroll") for (int _i = 0; _i < 2; ++_i) \
        __builtin_amdgcn_global_load_lds((const unsigned*)((const char*)(gbase) + (voff)[_i]), (PG8_LAS unsigned*)(lds + (bufoff) + ldsw + _i * 8192), 16, 0, 0); } while (0)
#define PG8_LDA(dst, b, h) do { _Pragma("unroll") for (int m = 0; m < 4; ++m) _Pragma("unroll") for (int k = 0; k < 2; ++k) dst[m][k] = *(const PG8_LAS bf16x8*)(lds + PG8_SA(b, h) + aoff + m * 2048 + k * 1024); } while (0)
#define PG8_LDB(dst, b, h) do { _Pragma("unroll") for (int n = 0; n < 2; ++n) _Pragma("unroll") for (int k = 0; k < 2; ++k) dst[n][k] = *(const PG8_LAS bf16x8*)(lds + PG8_SB(b, h) + boff + n * 2048 + k * 1024); } while (0)
#define PG8_MMA(ai, bj, At, Bt) do { __builtin_amdgcn_s_setprio(1); _Pragma("unroll") for (int m = 0; m < 4; ++m) _Pragma("unroll") for (int n = 0; n < 2; ++n) _Pragma("unroll") for (int k = 0; k < 2; ++k) \
        acc[ai][bj][m][n] = __builtin_amdgcn_mfma_f32_16x16x32_bf16(Bt[n][k], At[m][k], acc[ai][bj][m][n], 0, 0, 0); __builtin_amdgcn_s_setprio(0); } while (0)
#define PG8_WAIT_V(n) asm volatile("s_waitcnt vmcnt(" #n ")" ::: "memory")
#define PG8_WAIT_L(n) asm volatile("s_waitcnt lgkmcnt(" #n ")" ::: "memory")
#define PG8_BAR __builtin_amdgcn_s_barrier()
#define PG8_SCHED __builtin_amdgcn_sched_barrier(0)
    Unit cur, nxt; int ui = 0;
    if (!S.next(0, cur)) return;
    f32x4 acc[2][2][4][2];
#pragma unroll
    for (int a = 0; a < 2; ++a)
#pragma unroll
        for (int b = 0; b < 2; ++b)
#pragma unroll
            for (int m = 0; m < 4; ++m)
#pragma unroll
                for (int n = 0; n < 2; ++n) acc[a][b][m][n] = (f32x4){0.f, 0.f, 0.f, 0.f};
    bf16x8 At[4][2], B0[2][2], B1[2][2];
    const char* cA = (const char*)g.A + (size_t)cur.pm * tstep; const char* cB = (const char*)g.Bt + (size_t)cur.pn * tstep;
    S.a_ready(cur);
    if constexpr (SP2) {
        PG8_STAGE(PG8_SB(0, 0), cB, voffB); PG8_STAGE(PG8_SB(0, 1), cB + hstep, voffB); PG8_STAGE(PG8_SA(0, 0), cA, voffA); PG8_STAGE(PG8_SA(0, 1), cA + hstep, voffA);
        if (wr == 1) PG8_BAR;
        PG8_WAIT_V(2); PG8_BAR;
        PG8_STAGE(PG8_SB(1, 0), cB + kstep, voffB); PG8_STAGE(PG8_SA(1, 0), cA + kstep, voffA); PG8_STAGE(PG8_SB(1, 1), cB + hstep + kstep, voffB);
        PG8_WAIT_V(6); PG8_BAR;
    } else {
        PG8_STAGE(PG8_SB(0, 0), cB, voffB); PG8_STAGE(PG8_SA(0, 0), cA, voffA); PG8_STAGE(PG8_SB(0, 1), cB + hstep, voffB); PG8_STAGE(PG8_SA(0, 1), cA + hstep, voffA);
        if (wr == 1) PG8_BAR;
        PG8_WAIT_V(4); PG8_BAR;
        PG8_STAGE(PG8_SB(1, 0), cB + kstep, voffB); PG8_STAGE(PG8_SA(1, 0), cA + kstep, voffA); PG8_STAGE(PG8_SB(1, 1), cB + hstep + kstep, voffB);
        PG8_WAIT_V(6); PG8_BAR;
    }
    for (;;) {
        const bool has_next = S.next(ui + 1, nxt);
        const char* nA = has_next ? (const char*)g.A + (size_t)nxt.pm * tstep : cA; const char* nB = has_next ? (const char*)g.Bt + (size_t)nxt.pn * tstep : cB;
        for (int t = 0; t < nt; t += 2) {
            const bool last = (t == nt - 2);
            const char* a1 = cA + (size_t)(t + 1) * kstep;
            const char* a2 = last ? nA : cA + (size_t)(t + 2) * kstep; const char* b2 = last ? nB : cB + (size_t)(t + 2) * kstep;
            const char* a3 = a2 + kstep; const char* b3 = b2 + kstep;
            if (last && has_next) S.a_ready(nxt);
            if constexpr (SP2) {
            PG8_LDB(B0, 0, 0); PG8_LDB(B1, 0, 1); PG8_SCHED; PG8_LDA(At, 0, 0); PG8_STAGE(PG8_SA(1, 1), a1 + hstep, voffA);
            PG8_WAIT_V(8); PG8_WAIT_L(0); PG8_BAR; PG8_MMA(0, 0, At, B0); PG8_MMA(0, 1, At, B1); PG8_BAR; PG8_SCHED;
            PG8_LDA(At, 0, 1); PG8_STAGE(PG8_SB(0, 0), b2, voffB); PG8_STAGE(PG8_SB(0, 1), b2 + hstep, voffB); PG8_STAGE(PG8_SA(0, 0), a2, voffA);
            PG8_WAIT_V(8); PG8_WAIT_L(0); PG8_BAR; PG8_MMA(1, 0, At, B0); PG8_MMA(1, 1, At, B1); PG8_BAR; PG8_SCHED;
            PG8_LDB(B0, 1, 0); PG8_LDB(B1, 1, 1); PG8_SCHED; PG8_LDA(At, 1, 0); PG8_STAGE(PG8_SA(0, 1), a2 + hstep, voffA);
            PG8_WAIT_V(8); PG8_WAIT_L(0); PG8_BAR; PG8_MMA(0, 0, At, B0); PG8_MMA(0, 1, At, B1); PG8_BAR; PG8_SCHED;
            PG8_LDA(At, 1, 1); PG8_STAGE(PG8_SB(1, 0), b3, voffB); PG8_STAGE(PG8_SB(1, 1), b3 + hstep, voffB); PG8_STAGE(PG8_SA(1, 0), a3, voffA);
            PG8_WAIT_V(8); PG8_WAIT_L(0); PG8_BAR; PG8_MMA(1, 0, At, B0); PG8_MMA(1, 1, At, B1); PG8_BAR; PG8_SCHED;
            } else {
            PG8_LDB(B0, 0, 0); PG8_SCHED; PG8_LDA(At, 0, 0); PG8_STAGE(PG8_SA(1, 1), a1 + hstep, voffA);
            PG8_WAIT_L(8); PG8_BAR; PG8_WAIT_L(0); PG8_MMA(0, 0, At, B0); PG8_BAR; PG8_SCHED;
            PG8_LDB(B1, 0, 1); PG8_STAGE(PG8_SB(0, 0), b2, voffB);
            PG8_BAR; PG8_WAIT_L(0); PG8_MMA(0, 1, At, B1); PG8_BAR;
            PG8_LDA(At, 0, 1); PG8_STAGE(PG8_SA(0, 0), a2, voffA);
            PG8_BAR; PG8_WAIT_L(0); PG8_MMA(1, 0, At, B0); PG8_BAR; PG8_SCHED;
            PG8_STAGE(PG8_SB(0, 1), b2 + hstep, voffB);
            PG8_WAIT_V(6); PG8_BAR; PG8_MMA(1, 1, At, B1); PG8_BAR;
            PG8_LDB(B0, 1, 0); PG8_SCHED; PG8_LDA(At, 1, 0); PG8_STAGE(PG8_SA(0, 1), a2 + hstep, voffA);
            PG8_WAIT_L(8); PG8_BAR; PG8_WAIT_L(0); PG8_MMA(0, 0, At, B0); PG8_BAR; PG8_SCHED;
            PG8_LDB(B1, 1, 1); PG8_STAGE(PG8_SB(1, 0), b3, voffB);
            PG8_BAR; PG8_WAIT_L(0); PG8_MMA(0, 1, At, B1); PG8_BAR;
            PG8_LDA(At, 1, 1); PG8_STAGE(PG8_SA(1, 0), a3, voffA);
            PG8_BAR; PG8_WAIT_L(0); PG8_MMA(1, 0, At, B0); PG8_BAR; PG8_SCHED;
            PG8_STAGE(PG8_SB(1, 1), b3 + hstep, voffB);
            PG8_WAIT_V(6); PG8_BAR; PG8_MMA(1, 1, At, B1); PG8_BAR;
            }
        }
        if constexpr (ALIGN_EPI) { if (wr == 0) PG8_BAR; }
        if constexpr (!Epi::AFTER_DRAIN) { E(acc, cur, wr, wc, fr, fq); S.done(cur); }
        if (!has_next) break;
#pragma unroll
        for (int a = 0; a < 2; ++a)
#pragma unroll
            for (int b = 0; b < 2; ++b)
#pragma unroll
                for (int m = 0; m < 4; ++m)
#pragma unroll
                    for (int n = 0; n < 2; ++n) acc[a][b][m][n] = (f32x4){0.f, 0.f, 0.f, 0.f};
        cur = nxt; cA = nA; cB = nB; ++ui;
        if constexpr (ALIGN_EPI) { if (wr == 1) PG8_BAR; }
    }
    PG8_WAIT_V(0);
    if constexpr (!ALIGN_EPI) { if (wr == 0) PG8_BAR; }
    PG8_BAR;
#undef PG8_SA
#undef PG8_SB
#undef PG8_STAGE
#undef PG8_LDA
#undef PG8_LDB
#undef PG8_MMA
#undef PG8_WAIT_V
#undef PG8_WAIT_L
#undef PG8_BAR
#undef PG8_SCHED
}
}

constexpr int NWAVES = 8;
constexpr int D = 2048, SEQ = 4096, NBP = 2, NBS = 8, LSMP = 4;
constexpr int MPROMPT = NBP * SEQ;
constexpr int MV = MPROMPT + NBS * LSMP;
constexpr int MP = 8448;
constexpr int FF = 5632, NUP = 2 * FF;
constexpr int AW = 1280, AH = 10, ADK = 128;
constexpr int BW = 768, NGRP = 3, HPG = 4, HD = 64;
constexpr int IN0 = 7444, IN0P = 7680, PLD = 7424;
constexpr int QB_OFF = 5120;
constexpr int IN1 = 6144;
constexpr int NSEQ = 10, NMOD = 9 * D;
constexpr int PASTLEN = 16384;
constexpr float EPS = 1e-6f;
constexpr float B_SCALE = 0.125f;
__host__ __device__ __forceinline__ int swaW(int g) { return 128 << (2 * g); }
__host__ __device__ __forceinline__ int swaD(int g) { return 1 << (2 * g); }

constexpr size_t O_YP = 0, O_YS = O_YP + (size_t)MPROMPT * D, O_PS = O_YS + (size_t)NBS * LSMP * D, O_PCONV = O_PS + (size_t)NBP * AH * 128 * 128,
    O_PKV0 = O_PCONV + (size_t)NBP * 3 * 3840, O_PKV1 = O_PKV0 + (size_t)NBP * 128 * 512, O_PKV2 = O_PKV1 + (size_t)NBP * 512 * 512, O_PSC = O_PKV2 + (size_t)NBP * 2048 * 512,
    O_SS = O_PSC + (size_t)NBP * 2 * D, O_SCONV = O_SS + (size_t)NBS * AH * 128 * 128, O_SKV0 = O_SCONV + (size_t)NBS * 3 * 3840, O_SKV1 = O_SKV0 + (size_t)NBS * 128 * 512,
    O_SKV2 = O_SKV1 + (size_t)NBS * 512 * 512, O_SSC = O_SKV2 + (size_t)NBS * 2048 * 512, O_END = O_SSC + (size_t)NBS * 2 * D;
static_assert(O_END == 32399872, "output size");

constexpr size_t MiB = 1u << 20;
constexpr size_t WS_CTL = 0, CTL_ZERO_BYTES = 1 * MiB;
constexpr size_t WS_MOD = 1 * MiB;
constexpr size_t WS_G = 3 * MiB;
constexpr size_t WS_BETA = 4 * MiB;
constexpr size_t WS_LSE = 5 * MiB;
constexpr size_t WS_AB = 6 * MiB;
constexpr size_t WS_WUP = 8 * MiB;
constexpr size_t WUP_STRIDE = (size_t)NUP * D * 2;
constexpr size_t WS_WDN = WS_WUP + 4 * WUP_STRIDE;
constexpr size_t WDN_STRIDE = (size_t)D * FF * 2;
constexpr size_t WS_WIN0 = WS_WDN + 4 * WDN_STRIDE;
constexpr size_t WS_WOUT0 = WS_WIN0 + (size_t)IN0P * D * 2;
constexpr size_t WS_WIN1 = WS_WOUT0 + (size_t)D * D * 2;
constexpr size_t WS_WOUT1 = WS_WIN1 + (size_t)IN1 * D * 2;
constexpr size_t WS_X = WS_WOUT1 + (size_t)D * D * 2;
constexpr size_t WS_H = WS_X + (size_t)MP * D * 4;
constexpr size_t WS_ACT = WS_H + (size_t)MP * D * 2;
constexpr size_t WS_PROJ = WS_ACT + (size_t)MP * FF * 2;
constexpr size_t WS_MIX = WS_PROJ + (size_t)MP * PLD * 2;
constexpr size_t WS_QKVC = WS_MIX + (size_t)MP * D * 2;
constexpr size_t WS_OA = WS_QKVC + (size_t)MP * 3840 * 2;
constexpr size_t WS_OB = WS_OA + (size_t)MP * AW * 4;
constexpr size_t WS_GT = WS_OB + (size_t)MP * BW * 4;
constexpr size_t WS_CHK = WS_GT + 8192;
constexpr size_t CHK_STRIDE = 90112, CHK_WN = 32768, CHK_QD = 49152, CHK_QK = 65536, CHK_KD = 73728;
constexpr int N_CHUNK_UNITS = NBP * AH * (SEQ / 64);
constexpr size_t WS_END = WS_CHK + (size_t)N_CHUNK_UNITS * CHK_STRIDE;
static_assert(WS_MOD + (size_t)2 * NSEQ * NMOD * 4 <= WS_G && WS_AB + (size_t)MP * 32 * 4 <= WS_WUP, "small buffers");
static_assert(WS_WUP % 256 == 0 && WS_X % 256 == 0 && WS_H % 256 == 0 && WS_ACT % 256 == 0 && WS_PROJ % 256 == 0 && WS_MIX % 256 == 0 && WS_QKVC % 256 == 0 && WS_OA % 256 == 0 && WS_OB % 256 == 0 && WS_CHK % 256 == 0, "alignment");

constexpr int CW_TMO = 0, CW_CODE = 1;
constexpr int CW_BAR = 4096;

constexpr int RING_OFF = 0, RING_BYTES = 131072;
constexpr int LDSCTL_OFF = RING_BYTES, MISC_OFF = LDSCTL_OFF + 320;
constexpr int LDS_BYTES = 147456;
constexpr int SM_OFF = RING_BYTES + 1024, SM_WAVE = 1536;
static_assert(MISC_OFF + 128 <= LDS_BYTES, "LDS map");

#define GAS __attribute__((address_space(1)))
#define LAS __attribute__((address_space(3)))
typedef unsigned short bf16;
typedef unsigned v4u __attribute__((ext_vector_type(4)));
typedef unsigned v2u __attribute__((ext_vector_type(2)));
typedef float f32x4 __attribute__((ext_vector_type(4)));
typedef float f32x2 __attribute__((ext_vector_type(2)));
typedef GAS unsigned gu32;
typedef float f32x16 __attribute__((ext_vector_type(16)));
typedef short bf16x8s __attribute__((ext_vector_type(8)));
#define RLX_AGENT __ATOMIC_RELAXED, __HIP_MEMORY_SCOPE_AGENT
#define LDS_WAIT() asm volatile("s_waitcnt lgkmcnt(0)" ::: "memory")
#define VM_WAIT() asm volatile("s_waitcnt vmcnt(0)" ::: "memory")
__device__ __forceinline__ unsigned f2bf(float f) { unsigned u = __builtin_bit_cast(unsigned, f); return (u + 0x7fffu + ((u >> 16) & 1u)) >> 16; }
__device__ __forceinline__ unsigned pk2(float lo, float hi) { return f2bf(lo) | (f2bf(hi) << 16); }
__device__ __forceinline__ float bf_lo(unsigned w) { return __builtin_bit_cast(float, w << 16); }
__device__ __forceinline__ float bf_hi(unsigned w) { return __builtin_bit_cast(float, w & 0xffff0000u); }
__device__ __forceinline__ float bf2f(bf16 h) { return __builtin_bit_cast(float, (unsigned)h << 16); }

#define XB_TMO      128
#define XB_XCNT(j)  (256  + 64 * (j))
#define XB_XSUB(j)  (1280 + 64 * (j))
#define XB_XGEN(j)  (2304 + 64 * (j))
#define XB_TOP      3328
#define XB_TOPGEN   3392
#define XCD_BAR_WORDS 3456
#define XB_SPIN_CAP (1u << 18)

__device__ __forceinline__ unsigned xb_ld(unsigned* p)              { return __hip_atomic_load(p, __ATOMIC_RELAXED, __HIP_MEMORY_SCOPE_AGENT); }
__device__ __forceinline__ unsigned xb_add(unsigned* p, unsigned v) { return __hip_atomic_fetch_add(p, v, __ATOMIC_RELAXED, __HIP_MEMORY_SCOPE_AGENT); }
__device__ __forceinline__ unsigned xb_xcc_id() { return (unsigned)__builtin_amdgcn_s_getreg((3 << 11) | 20) & 0xFu; }
#define XB_SPIN(cond, bar) do { unsigned _sp = 0; while (cond) { __builtin_amdgcn_s_sleep(1); \
    if ((++_sp & 255u) == 0u) { if (xb_ld(&(bar)[XB_TMO])) break; if (_sp > XB_SPIN_CAP) { atomicAdd(&(bar)[XB_TMO], 1u); break; } } } } while (0)

struct XcdBarrier {
    unsigned* bar; unsigned x;
    volatile LAS unsigned* st;
};
__device__ __forceinline__ XcdBarrier xcd_barrier_post(unsigned* bar, volatile LAS unsigned* st) {
    XcdBarrier b; b.bar = bar; b.x = xb_xcc_id(); b.st = st;
    if (threadIdx.x == 0) (void)xb_add(&bar[XB_XCNT(b.x)], 1u);
    return b;
}
__device__ __forceinline__ void xcd_barrier_complete(unsigned* bar, unsigned x, unsigned& nloc, unsigned& nx) {
    const unsigned G = gridDim.x * gridDim.y * gridDim.z;
    unsigned sum, cnt, mine, sp = 0u;
    for (;;) {
        sum = 0u; cnt = 0u; mine = 0u;
#pragma unroll
        for (unsigned j = 0; j < 16; ++j) { const unsigned c = xb_ld(&bar[XB_XCNT(j)]); sum += c; cnt += (c > 0u) ? 1u : 0u; mine = (j == x) ? c : mine; }
        if (sum == G) break;
        __builtin_amdgcn_s_sleep(1);
        if ((++sp & 255u) == 0u) { if (xb_ld(&bar[XB_TMO])) break; if (sp > XB_SPIN_CAP) { atomicAdd(&bar[XB_TMO], 1u); break; } }
    }
    nloc = mine > 0u ? mine : 1u; nx = cnt > 0u ? cnt : 1u;
}
__device__ __forceinline__ void xcd_barrier(const XcdBarrier& b) {
    asm volatile("s_waitcnt vmcnt(0)" ::: "memory");
    __syncthreads();
    if (threadIdx.x == 0) {
        unsigned* bar = b.bar;
        __builtin_amdgcn_s_waitcnt(0);
        unsigned nloc = b.st[0], nx = b.st[1];
        if (nloc == 0u) { xcd_barrier_complete(bar, b.x, nloc, nx); b.st[0] = nloc; b.st[1] = nx; }
        const unsigned old = xb_add(&bar[XB_XSUB(b.x)], 1u);
        const unsigned gen = old / nloc;
        if (old + 1u == (gen + 1u) * nloc) {
            __builtin_amdgcn_fence(__ATOMIC_RELEASE, "agent");
            asm volatile("s_waitcnt vmcnt(0)" ::: "memory");
            const unsigned og = xb_add(&bar[XB_TOP], 1u);
            const unsigned tg = og / nx;
            if (og + 1u == (tg + 1u) * nx) xb_add(&bar[XB_TOPGEN], 1u);
            else XB_SPIN(xb_ld(&bar[XB_TOPGEN]) == tg, bar);
            __builtin_amdgcn_fence(__ATOMIC_ACQUIRE, "agent");
            xb_add(&bar[XB_XGEN(b.x)], 1u);
            asm volatile("s_waitcnt vmcnt(0)" ::: "memory");
        } else {
            XB_SPIN(xb_ld(&bar[XB_XGEN(b.x)]) == gen, bar);
            __builtin_amdgcn_fence(__ATOMIC_ACQUIRE, "agent");
            asm volatile("s_waitcnt vmcnt(0)" ::: "memory");
        }
    }
    __syncthreads();
}

struct Args { const float* in[27]; float* out; unsigned char* ws; int ph_lo, ph_hi; };
struct Frame {
    LAS unsigned char* lds;
    volatile LAS unsigned* MISC;
    gu32* ctl;
    int tid, lane, wave;
    int vcu, G;
    float* out;
    unsigned char* ws;
};

__device__ __forceinline__ float wave_sum(float v) {
#pragma unroll
    for (int o = 1; o < 64; o <<= 1) v += __shfl_xor(v, o);
    return v;
}
__device__ __forceinline__ float wave_max(float v) {
#pragma unroll
    for (int o = 1; o < 64; o <<= 1) v = fmaxf(v, __shfl_xor(v, o));
    return v;
}

__device__ __forceinline__ int src_col(int kind, int rr) {
    if (kind == 0) return rr;
    if (kind == 1) { const int t = rr >> 8, cc = rr & 255; return cc < 128 ? t * 128 + cc : FF + t * 128 + (cc - 128); }
    if (kind == 2) { if (rr < 5120) return rr; if (rr < 7424) return rr + 20; if (rr < 7444) return rr - 7424 + 5120; return -1; }
    if (rr < 2048) return rr;
    { const int q = rr - 2048, t = q >> 8, cc = q & 255; return cc < 128 ? 2048 + t * 128 + cc : 4096 + t * 128 + (cc - 128); }
}
__device__ __forceinline__ void p0_transpose_item(const float* W, int K, int N, bf16* WT, int kind, LAS float* scr, int item, int nblk, int lane) {
    const int kb = item / nblk, nb = item % nblk, k0 = 64 * kb, n0 = 32 * nb;
    const int sc = src_col(kind, n0 + (lane & 31));
#pragma unroll 8
    for (int i = 0; i < 32; ++i) { const int kk = 2 * i + (lane >> 5); scr[kk * 33 + (lane & 31)] = sc >= 0 ? W[(size_t)(k0 + kk) * N + sc] : 0.f; }
    LDS_WAIT(); asm volatile("" ::: "memory");
    const int c = lane & 7;
#pragma unroll
    for (int j = 0; j < 4; ++j) { const int n = (lane >> 3) + 8 * j; const LAS float* s = scr + (8 * c) * 33 + n;
        v4u o; o.x = pk2(s[0 * 33], s[1 * 33]); o.y = pk2(s[2 * 33], s[3 * 33]); o.z = pk2(s[4 * 33], s[5 * 33]); o.w = pk2(s[6 * 33], s[7 * 33]);
        *(GAS v4u*)(WT + (size_t)(n0 + n) * K + k0 + 8 * c) = o; }
    LDS_WAIT(); asm volatile("" ::: "memory");
}
__device__ __forceinline__ void p0_weights(Frame& F, const Args& args) {
    LAS float* scr = (LAS float*)(F.lds + RING_OFF + F.wave * 16384);
    const int gw = F.vcu * NWAVES + F.wave, NGW = F.G * NWAVES;
    constexpr int I_UP = (D / 64) * (NUP / 32), I_DN = (FF / 64) * (D / 32), I_IN0 = (D / 64) * (IN0P / 32), I_O = (D / 64) * (D / 32), I_IN1 = (D / 64) * (IN1 / 32);
    constexpr int NITEMS = 4 * I_UP + 4 * I_DN + I_IN0 + I_O + I_IN1 + I_O;
    for (int it = gw; it < NITEMS; it += NGW) {
        int r = it;
        if (r < 4 * I_UP) { const int w = r / I_UP; r -= w * I_UP;
            p0_transpose_item((args.in[16]) + (size_t)w * D * NUP, D, NUP, (bf16*)(F.ws + WS_WUP + w * WUP_STRIDE), 1, scr, r, NUP / 32, F.lane); continue; }
        r -= 4 * I_UP;
        if (r < 4 * I_DN) { const int w = r / I_DN; r -= w * I_DN;
            p0_transpose_item((args.in[17]) + (size_t)w * FF * D, FF, D, (bf16*)(F.ws + WS_WDN + w * WDN_STRIDE), 0, scr, r, D / 32, F.lane); continue; }
        r -= 4 * I_DN;
        if (r < I_IN0) { p0_transpose_item((args.in[18]), D, IN0, (bf16*)(F.ws + WS_WIN0), 2, scr, r, IN0P / 32, F.lane); continue; }
        r -= I_IN0;
        if (r < I_O) { p0_transpose_item((args.in[23]), D, D, (bf16*)(F.ws + WS_WOUT0), 0, scr, r, D / 32, F.lane); continue; }
        r -= I_O;
        if (r < I_IN1) { p0_transpose_item((args.in[24]), D, IN1, (bf16*)(F.ws + WS_WIN1), 3, scr, r, IN1 / 32, F.lane); continue; }
        r -= I_IN1;
        p0_transpose_item((args.in[26]), D, D, (bf16*)(F.ws + WS_WOUT1), 0, scr, r, D / 32, F.lane);
    }
}
__device__ __forceinline__ void p0_mod(Frame& F, const Args& args) {
    LAS float* SC = (LAS float*)(F.lds + RING_OFF);
    LAS float* RED = (LAS float*)(F.lds + RING_OFF + 81920);
    __syncthreads();
    for (int i = F.tid; i < NSEQ * D; i += NWAVES * 64) { const int s = i / D, k = i % D; const float c = s < NBP ? (args.in[2])[s * D + k] : (args.in[3])[(s - NBP) * D + k];
        SC[k * NSEQ + s] = c / (1.0f + __expf(-c)); }
    __syncthreads();
    for (int slab = F.vcu; slab < 256; slab += F.G) {
        const int l = slab >> 7, n0 = (slab & 127) * 144;
        float acc[NSEQ][4];
#pragma unroll
        for (int s = 0; s < NSEQ; ++s) { acc[s][0] = 0.f; acc[s][1] = 0.f; acc[s][2] = 0.f; acc[s][3] = 0.f; }
        if (F.lane < 36) {
            const float* wp = (args.in[10]) + ((size_t)l * D + F.wave * 256) * NMOD + n0 + 4 * F.lane;
            const LAS float* sp = SC + (F.wave * 256) * NSEQ;
#pragma unroll 8
            for (int k = 0; k < 256; ++k) { const f32x4 w = *(const f32x4*)(wp + (size_t)k * NMOD);
#pragma unroll
                for (int s = 0; s < NSEQ; ++s) { const float c = sp[k * NSEQ + s]; acc[s][0] += c * w[0]; acc[s][1] += c * w[1]; acc[s][2] += c * w[2]; acc[s][3] += c * w[3]; } }
#pragma unroll
            for (int s = 0; s < NSEQ; ++s)
#pragma unroll
                for (int j = 0; j < 4; ++j) RED[(F.wave * NSEQ + s) * 144 + 4 * F.lane + j] = acc[s][j];
        }
        __syncthreads();
        for (int i = F.tid; i < NSEQ * 144; i += NWAVES * 64) { const int s = i / 144, j = i % 144; float v = (args.in[11])[l * NMOD + n0 + j];
#pragma unroll
            for (int w = 0; w < 8; ++w) v += RED[(w * NSEQ + s) * 144 + j];
            ((float*)(F.ws + WS_MOD))[((size_t)l * NSEQ + s) * NMOD + n0 + j] = v; }
        __syncthreads();
    }
}

__device__ __forceinline__ void norm_phase(Frame& F, const Args& args, const float* gain, const float* shift, const float* scale, bool first) {
    const int gw = F.vcu * NWAVES + F.wave, NGW = F.G * NWAVES;
    for (int m = gw; m < MP; m += NGW) {
        GAS v4u* o16 = (GAS v4u*)(((bf16*)(F.ws + WS_H)) + (size_t)m * D);
        if (m >= MV) {
#pragma unroll
            for (int j = 0; j < 4; ++j) o16[64 * j + F.lane] = (v4u){0u, 0u, 0u, 0u};
            continue; }
        const float* src = first ? (m < MPROMPT ? (args.in[0]) + (size_t)m * D : (args.in[1]) + (size_t)(m - MPROMPT) * D) : ((float*)(F.ws + WS_X)) + (size_t)m * D;
        const int seq = pg8::seq_of_row(m);
        f32x4 v[4][2]; float ss = 0.f;
#pragma unroll
        for (int j = 0; j < 4; ++j)
#pragma unroll
            for (int h = 0; h < 2; ++h) { v[j][h] = *(const f32x4*)(src + 512 * j + 8 * F.lane + 4 * h); ss += (v[j][h].x * v[j][h].x + v[j][h].y * v[j][h].y) + (v[j][h].z * v[j][h].z + v[j][h].w * v[j][h].w); }
        if (first) {
#pragma unroll
            for (int j = 0; j < 4; ++j)
#pragma unroll
                for (int h = 0; h < 2; ++h) *(f32x4*)(((float*)(F.ws + WS_X)) + (size_t)m * D + 512 * j + 8 * F.lane + 4 * h) = v[j][h]; }
        const float rstd = 1.0f / sqrtf(wave_sum(ss) * (1.0f / D) + EPS);
        const float* shp = shift + (size_t)seq * NMOD; const float* scp = scale + (size_t)seq * NMOD;
#pragma unroll
        for (int j = 0; j < 4; ++j) { float r[8];
#pragma unroll
            for (int h = 0; h < 2; ++h) { const int e = 512 * j + 8 * F.lane + 4 * h; const f32x4 g = *(const f32x4*)(gain + e), sh = *(const f32x4*)(shp + e), sc = *(const f32x4*)(scp + e);
                const f32x4 y = (v[j][h] * rstd) * g * (sc + 1.0f) + sh; r[4 * h + 0] = y.x; r[4 * h + 1] = y.y; r[4 * h + 2] = y.z; r[4 * h + 3] = y.w; }
            v4u o; o.x = pk2(r[0], r[1]); o.y = pk2(r[2], r[3]); o.z = pk2(r[4], r[5]); o.w = pk2(r[6], r[7]);
            o16[64 * j + F.lane] = o; }
    }
}
__device__ __forceinline__ void final_norm_phase(Frame& F, const Args& args) {
    const int gw = F.vcu * NWAVES + F.wave, NGW = F.G * NWAVES;
    for (int m = gw; m < MV; m += NGW) {
        const float* src = ((float*)(F.ws + WS_X)) + (size_t)m * D; float* dst = F.out + O_YP + (size_t)m * D;
        f32x4 v[8]; float ss = 0.f;
#pragma unroll
        for (int j = 0; j < 8; ++j) { v[j] = *(const f32x4*)(src + 256 * j + 4 * F.lane); ss += (v[j].x * v[j].x + v[j].y * v[j].y) + (v[j].z * v[j].z + v[j].w * v[j].w); }
        const float rstd = 1.0f / sqrtf(wave_sum(ss) * (1.0f / D) + EPS);
#pragma unroll
        for (int j = 0; j < 8; ++j) { const f32x4 g = *(const f32x4*)((args.in[15]) + 256 * j + 4 * F.lane); *(f32x4*)(dst + 256 * j + 4 * F.lane) = (v[j] * rstd) * g; }
    }
}

__device__ __forceinline__ float softplus_f(float x) { return x > 20.f ? x : log1pf(__expf(x)); }
__device__ __forceinline__ void gdn_prep(Frame& F, const Args& args) {
    const int gw = F.vcu * NWAVES + F.wave, NGW = F.G * NWAVES;
    for (int id = gw; id < MV * AH; id += NGW) {
        const int m = id / AH, h = id % AH;
        const bool smp = m >= MPROMPT; const int t = smp ? ((m - MPROMPT) & 3) : (m & (SEQ - 1)); const int sb = smp ? ((m - MPROMPT) >> 2) : 0;
        float y[3][2];
#pragma unroll
        for (int part = 0; part < 3; ++part) {
            const int c = part * AW + h * ADK + 2 * F.lane;
            float a0 = 0.f, a1 = 0.f;
#pragma unroll
            for (int j = 0; j < 4; ++j) { const int tt = t - 3 + j; float x0, x1;
                if (tt >= 0) { const unsigned w = *(const unsigned*)(((bf16*)(F.ws + WS_PROJ)) + (size_t)(m - t + tt) * PLD + c); x0 = bf_lo(w); x1 = bf_hi(w); }
                else if (smp) { const f32x2 w = *(const f32x2*)((args.in[5]) + (size_t)(sb * 3 + (3 + tt)) * 3840 + c); x0 = w.x; x1 = w.y; }
                else { x0 = 0.f; x1 = 0.f; }
                const f32x2 cw = *(const f32x2*)((args.in[19]) + (size_t)j * 3840 + c); a0 += cw.x * x0; a1 += cw.y * x1; }
            y[part][0] = a0 / (1.0f + __expf(-a0)); y[part][1] = a1 / (1.0f + __expf(-a1));
        }
        const float sq = wave_sum(y[0][0] * y[0][0] + y[0][1] * y[0][1]), sk = wave_sum(y[1][0] * y[1][0] + y[1][1] * y[1][1]);
        const float rq = (1.0f / sqrtf(sq + EPS)) * 0.08838834764831845f, rk = 1.0f / sqrtf(sk + EPS);
        bf16* qrow = ((bf16*)(F.ws + WS_QKVC)) + (size_t)m * 3840 + h * ADK + 2 * F.lane;
        *(unsigned*)(qrow) = pk2(y[0][0] * rq, y[0][1] * rq); *(unsigned*)(qrow + AW) = pk2(y[1][0] * rk, y[1][1] * rk); *(unsigned*)(qrow + 2 * AW) = pk2(y[2][0], y[2][1]);
        if (F.lane == 0) { const float aa = ((float*)(F.ws + WS_AB))[(size_t)m * 32 + h], bb = ((float*)(F.ws + WS_AB))[(size_t)m * 32 + 10 + h];
            ((float*)(F.ws + WS_G))[(size_t)m * AH + h] = -__expf((args.in[20])[h]) * softplus_f(aa + (args.in[21])[h]); ((float*)(F.ws + WS_BETA))[(size_t)m * AH + h] = 1.0f / (1.0f + __expf(-bb)); }
    }
}
__device__ __forceinline__ void swa_prompt(Frame& F, const Args& args) {
    LAS unsigned* Ks = (LAS unsigned*)(F.lds + RING_OFF);
    LAS unsigned* Vs = (LAS unsigned*)(F.lds + RING_OFF + 25600);
    LAS float* Qs = (LAS float*)(F.lds + RING_OFF + 51200);
    LAS float* Ps = (LAS float*)(F.lds + RING_OFF + 51200 + 16384) + F.wave * 132;
    for (int u = F.vcu; u < 1536; u += F.G) {
        const int b = u / 768, r1 = u % 768, g = r1 >> 8, r2 = r1 & 255, hs = r2 >> 6, rb = r2 & 63;
        const int d = swaD(g), nqb = 64 / d, res = rb / nqb, qb = rb % nqb, s0 = qb * 64;
        const int hcol = (g * HPG + hs) * HD;
        __syncthreads();
        {
            const int ch = F.tid & 7;
#pragma unroll
            for (int p = 0; p < 3; ++p) { const int j = (F.tid >> 3) + 64 * p, s = s0 - 128 + j;
                v4u kv = (v4u){0u, 0u, 0u, 0u}, vv = kv;
                if (s >= 0) { const bf16* rowp = ((bf16*)(F.ws + WS_PROJ)) + (size_t)(b * SEQ + res + d * s) * PLD + QB_OFF + hcol + 8 * ch; kv = *(const v4u*)(rowp + BW); vv = *(const v4u*)(rowp + 2 * BW); }
                LAS unsigned* kd = Ks + j * 33 + 4 * ch; kd[0] = kv.x; kd[1] = kv.y; kd[2] = kv.z; kd[3] = kv.w;
                LAS unsigned* vd = Vs + j * 33 + 4 * ch; vd[0] = vv.x; vd[1] = vv.y; vd[2] = vv.z; vd[3] = vv.w; }
            { const int i = F.tid >> 3; const bf16* rowp = ((bf16*)(F.ws + WS_PROJ)) + (size_t)(b * SEQ + res + d * (s0 + i)) * PLD + QB_OFF + hcol + 8 * ch; const v4u qv = *(const v4u*)rowp;
              LAS float* qd = Qs + i * 64 + 8 * ch;
              qd[0] = bf_lo(qv.x) * B_SCALE; qd[1] = bf_hi(qv.x) * B_SCALE; qd[2] = bf_lo(qv.y) * B_SCALE; qd[3] = bf_hi(qv.y) * B_SCALE;
              qd[4] = bf_lo(qv.z) * B_SCALE; qd[5] = bf_hi(qv.z) * B_SCALE; qd[6] = bf_lo(qv.w) * B_SCALE; qd[7] = bf_hi(qv.w) * B_SCALE; }
        }
        __syncthreads();
        for (int qi = 0; qi < 8; ++qi) {
            const int i = F.wave * 8 + qi;
            const int j1 = i + F.lane, j2 = i + 64 + F.lane, j3 = i + 128;
            float a1 = 0.f, a2 = 0.f;
#pragma unroll 8
            for (int c = 0; c < 32; ++c) { const f32x2 q = *(const LAS f32x2*)(Qs + i * 64 + 2 * c); const unsigned k1 = Ks[j1 * 33 + c], k2 = Ks[j2 * 33 + c];
                a1 += q.x * bf_lo(k1) + q.y * bf_hi(k1); a2 += q.x * bf_lo(k2) + q.y * bf_hi(k2); }
            float a3; { const unsigned k3 = Ks[j3 * 33 + (F.lane >> 1)]; const float kk = (F.lane & 1) ? bf_hi(k3) : bf_lo(k3); a3 = wave_sum(Qs[i * 64 + F.lane] * kk); }
            if (s0 - 128 + j1 < 0) a1 = -INFINITY;
            if (s0 - 128 + j2 < 0) a2 = -INFINITY;
            const float mx = wave_max(fmaxf(fmaxf(a1, a2), a3));
            const float p1 = __expf(a1 - mx), p2 = __expf(a2 - mx), p3 = __expf(a3 - mx);
            const float den = wave_sum(p1 + p2) + p3, rden = 1.0f / den;
            Ps[F.lane] = p1 * rden; Ps[64 + F.lane] = p2 * rden; if (F.lane == 0) Ps[128] = p3 * rden;
            LDS_WAIT(); asm volatile("" ::: "memory");
            float o = 0.f;
            const LAS bf16* vcol = (const LAS bf16*)Vs + F.lane;
#pragma unroll 4
            for (int jj = 0; jj < 129; ++jj) o += Ps[jj] * bf2f(vcol[(i + jj) * 66]);
            const size_t mq = (size_t)(b * SEQ + res + d * (s0 + i));
            ((float*)(F.ws + WS_OB))[mq * BW + hcol + F.lane] = o;
            if (F.lane == 0) ((float*)(F.ws + WS_LSE))[mq * 12 + g * HPG + hs] = mx + __logf(den);
            LDS_WAIT(); asm volatile("" ::: "memory");
        }
    }
    __syncthreads();
}
__device__ __forceinline__ void swa_sample(Frame& F, const Args& args) {
    LAS float* Ps = (LAS float*)(F.lds + RING_OFF + 51200 + 16384) + F.wave * 132;
    const int gw = F.vcu * NWAVES + F.wave, NGW = F.G * NWAVES;
    for (int id = gw; id < NBS * LSMP * 12; id += NGW) {
        const int sb = id / 48, r1 = id % 48, t = r1 / 12, gh = r1 % 12, g = gh >> 2, hs = gh & 3;
        const int d = swaD(g), W = swaW(g);
        const float* cache = g == 0 ? (args.in[6]) : (g == 1 ? (args.in[7]) : (args.in[8]));
        const int hcol = gh * HD;
        const size_t mq = (size_t)(MPROMPT + sb * LSMP + t);
        const bf16* qrow = ((bf16*)(F.ws + WS_PROJ)) + mq * PLD + QB_OFF + hcol;
        float sc[3];
#pragma unroll
        for (int pass = 0; pass < 3; ++pass) {
            const int mm = pass * 64 + F.lane; float a = -INFINITY;
            if (mm <= 128) { const int p = t - d * mm; a = 0.f;
                if (p >= 0) { const bf16* kr = ((bf16*)(F.ws + WS_PROJ)) + (size_t)(MPROMPT + sb * LSMP + p) * PLD + QB_OFF + BW + hcol;
                    for (int e = 0; e < 64; e += 2) { const unsigned kw = *(const unsigned*)(kr + e), qw = *(const unsigned*)(qrow + e); a += bf_lo(qw) * bf_lo(kw) + bf_hi(qw) * bf_hi(kw); } }
                else { const float* kr = cache + ((size_t)(sb * W + (W + p)) * 2 + 0) * 256 + hs * HD;
                    for (int e = 0; e < 64; e += 2) { const f32x2 kw = *(const f32x2*)(kr + e); const unsigned qw = *(const unsigned*)(qrow + e); a += bf_lo(qw) * kw.x + bf_hi(qw) * kw.y; } }
                a *= B_SCALE; }
            sc[pass] = a;
        }
        const float mx = wave_max(fmaxf(fmaxf(sc[0], sc[1]), sc[2]));
        const float p0 = __expf(sc[0] - mx), p1 = __expf(sc[1] - mx), p2 = __expf(sc[2] - mx);
        const float den = wave_sum(p0 + p1 + p2), rden = 1.0f / den;
        Ps[F.lane] = p0 * rden; Ps[64 + F.lane] = p1 * rden; if (F.lane == 0) Ps[128] = p2 * rden;
        LDS_WAIT(); asm volatile("" ::: "memory");
        float o = 0.f;
        for (int mm = 0; mm <= 128; ++mm) { const int p = t - d * mm; float vv;
            if (p >= 0) vv = bf2f(((bf16*)(F.ws + WS_PROJ))[(size_t)(MPROMPT + sb * LSMP + p) * PLD + QB_OFF + 2 * BW + hcol + F.lane]);
            else vv = cache[((size_t)(sb * W + (W + p)) * 2 + 1) * 256 + hs * HD + F.lane];
            o += Ps[mm] * vv; }
        ((float*)(F.ws + WS_OB))[mq * BW + hcol + F.lane] = o;
        if (F.lane == 0) ((float*)(F.ws + WS_LSE))[mq * 12 + gh] = mx + __logf(den);
        LDS_WAIT(); asm volatile("" ::: "memory");
    }
}
__device__ __forceinline__ void mixer0_copies(Frame& F, const Args& args) {
    const long gt = (long)F.vcu * (NWAVES * 64) + F.tid, NGT = (long)F.G * NWAVES * 64;
    for (long i = gt; i < (long)(NBP + NBS) * 3 * 3840; i += NGT) { const int c = (int)(i % 3840), j = (int)((i / 3840) % 3), s = (int)(i / (3 * 3840));
        if (s < NBP) F.out[O_PCONV + (size_t)(s * 3 + j) * 3840 + c] = bf2f(((bf16*)(F.ws + WS_PROJ))[(size_t)(s * SEQ + SEQ - 3 + j) * PLD + c]);
        else { const int sb = s - NBP; F.out[O_SCONV + (size_t)(sb * 3 + j) * 3840 + c] = bf2f(((bf16*)(F.ws + WS_PROJ))[(size_t)(MPROMPT + sb * LSMP + 1 + j) * PLD + c]); } }
#pragma unroll
    for (int g = 0; g < 3; ++g) {
        const int W = g == 0 ? 128 : (g == 1 ? 512 : 2048);
        const size_t op = g == 0 ? O_PKV0 : (g == 1 ? O_PKV1 : O_PKV2), os = g == 0 ? O_SKV0 : (g == 1 ? O_SKV1 : O_SKV2);
        const float* cache = g == 0 ? (args.in[6]) : (g == 1 ? (args.in[7]) : (args.in[8]));
        const long np = (long)NBP * W * 128, ns = (long)NBS * W * 128;
        for (long i = gt; i < np + ns; i += NGT) {
            const bool smp = i >= np; const long q = smp ? i - np : i;
            const int e4 = (int)(q & 15), hs = (int)((q >> 4) & 3), kv = (int)((q >> 6) & 1), j = (int)((q >> 7) % W), s = (int)((q >> 7) / W);
            const int pcol = QB_OFF + (kv + 1) * BW + (g * HPG + hs) * HD + 4 * e4;
            f32x4 v;
            if (!smp) { const v2u w = *(const v2u*)(((bf16*)(F.ws + WS_PROJ)) + (size_t)(s * SEQ + SEQ - W + j) * PLD + pcol); v = (f32x4){bf_lo(w.x), bf_hi(w.x), bf_lo(w.y), bf_hi(w.y)};
                *(f32x4*)(F.out + op + (size_t)q * 4) = v; }
            else { if (j < W - LSMP) v = *(const f32x4*)(cache + (((size_t)(s * W + j + LSMP) * 2 + kv) * 4 + hs) * 64 + 4 * e4);
                else { const v2u w = *(const v2u*)(((bf16*)(F.ws + WS_PROJ)) + (size_t)(MPROMPT + s * LSMP + (j - (W - LSMP))) * PLD + pcol); v = (f32x4){bf_lo(w.x), bf_hi(w.x), bf_lo(w.y), bf_hi(w.y)}; }
                *(f32x4*)(F.out + os + (size_t)q * 4) = v; }
        }
    }
}
__device__ __forceinline__ void gdn_scan_naive(Frame& F, const Args& args) {
    LAS bf16* Kb = (LAS bf16*)(F.lds + RING_OFF);
    LAS bf16* Qb = (LAS bf16*)(F.lds + RING_OFF + 16384);
    LAS bf16* Vb = (LAS bf16*)(F.lds + RING_OFF + 32768);
    LAS float* gb = (LAS float*)(F.lds + RING_OFF + 40960);
    LAS float* bb = gb + 64;
    for (int task = 2 * NBP * AH + (F.G - 1 - F.vcu); task < 200; task += F.G) {
        const int chain = task >> 1, hf = task & 1;
        const bool smp = chain >= NBP * AH;
        const int seq = smp ? NBP + (chain - NBP * AH) / AH : chain / AH, h = smp ? (chain - NBP * AH) % AH : chain % AH;
        const int L = smp ? LSMP : SEQ, m0 = smp ? MPROMPT + (seq - NBP) * LSMP : seq * SEQ;
        const int vc = F.lane & 7, kg = F.lane >> 3, v0 = hf * 64 + F.wave * 8;
        float s[16];
        if (smp) {
#pragma unroll
            for (int i = 0; i < 16; ++i) s[i] = (args.in[4])[(((size_t)(seq - NBP) * AH + h) * 128 + kg * 16 + i) * 128 + v0 + vc];
        } else {
#pragma unroll
            for (int i = 0; i < 16; ++i) s[i] = 0.f;
        }
        for (int t0 = 0; t0 < L; t0 += 64) {
            const int nb = (L - t0) < 64 ? (L - t0) : 64;
            __syncthreads();
            for (int i = F.tid; i < nb * 16; i += NWAVES * 64) { const int tt = i >> 4, ch = i & 15; const bf16* rowp = ((bf16*)(F.ws + WS_QKVC)) + (size_t)(m0 + t0 + tt) * 3840 + h * ADK + 8 * ch;
                *(LAS v4u*)(Qb + tt * 128 + 8 * ch) = *(const v4u*)rowp; *(LAS v4u*)(Kb + tt * 128 + 8 * ch) = *(const v4u*)(rowp + AW);
                if (ch < 8) *(LAS v4u*)(Vb + tt * 64 + 8 * ch) = *(const v4u*)(rowp + 2 * AW + hf * 64); }
            if (F.tid < nb) { gb[F.tid] = __expf(((float*)(F.ws + WS_G))[(size_t)(m0 + t0 + F.tid) * AH + h]); bb[F.tid] = ((float*)(F.ws + WS_BETA))[(size_t)(m0 + t0 + F.tid) * AH + h]; }
            __syncthreads();
            for (int tt = 0; tt < nb; ++tt) {
                const float a = gb[tt], be = bb[tt];
                const v4u k0 = *(const LAS v4u*)(Kb + tt * 128 + kg * 16), k1 = *(const LAS v4u*)(Kb + tt * 128 + kg * 16 + 8);
                const v4u q0 = *(const LAS v4u*)(Qb + tt * 128 + kg * 16), q1 = *(const LAS v4u*)(Qb + tt * 128 + kg * 16 + 8);
                const float vv = bf2f(Vb[tt * 64 + F.wave * 8 + vc]);
                float kf[16], qf[16];
                kf[0] = bf_lo(k0.x); kf[1] = bf_hi(k0.x); kf[2] = bf_lo(k0.y); kf[3] = bf_hi(k0.y); kf[4] = bf_lo(k0.z); kf[5] = bf_hi(k0.z); kf[6] = bf_lo(k0.w); kf[7] = bf_hi(k0.w);
                kf[8] = bf_lo(k1.x); kf[9] = bf_hi(k1.x); kf[10] = bf_lo(k1.y); kf[11] = bf_hi(k1.y); kf[12] = bf_lo(k1.z); kf[13] = bf_hi(k1.z); kf[14] = bf_lo(k1.w); kf[15] = bf_hi(k1.w);
                qf[0] = bf_lo(q0.x); qf[1] = bf_hi(q0.x); qf[2] = bf_lo(q0.y); qf[3] = bf_hi(q0.y); qf[4] = bf_lo(q0.z); qf[5] = bf_hi(q0.z); qf[6] = bf_lo(q0.w); qf[7] = bf_hi(q0.w);
                qf[8] = bf_lo(q1.x); qf[9] = bf_hi(q1.x); qf[10] = bf_lo(q1.y); qf[11] = bf_hi(q1.y); qf[12] = bf_lo(q1.z); qf[13] = bf_hi(q1.z); qf[14] = bf_lo(q1.w); qf[15] = bf_hi(q1.w);
                float part = 0.f;
#pragma unroll
                for (int i = 0; i < 16; ++i) { s[i] *= a; part += kf[i] * s[i]; }
                part += __shfl_xor(part, 8); part += __shfl_xor(part, 16); part += __shfl_xor(part, 32);
                const float dl = be * (vv - part);
                float op = 0.f;
#pragma unroll
                for (int i = 0; i < 16; ++i) { s[i] += kf[i] * dl; op += qf[i] * s[i]; }
                op += __shfl_xor(op, 8); op += __shfl_xor(op, 16); op += __shfl_xor(op, 32);
                if (kg == 0) ((float*)(F.ws + WS_OA))[(size_t)(m0 + t0 + tt) * AW + h * ADK + v0 + vc] = op;
            }
        }
        float* so = F.out + (smp ? O_SS + ((size_t)(seq - NBP) * AH + h) * 16384 : O_PS + ((size_t)seq * AH + h) * 16384);
#pragma unroll
        for (int i = 0; i < 16; ++i) so[(size_t)(kg * 16 + i) * 128 + v0 + vc] = s[i];
    }
    __syncthreads();
}

__device__ __forceinline__ unsigned cvtpk(float lo, float hi) { unsigned r; asm("v_cvt_pk_bf16_f32 %0, %1, %2" : "=v"(r) : "v"(lo), "v"(hi)); return r; }
__device__ __forceinline__ int pos4(int k4) { const int g = (k4 >> 2) & 3; return (k4 & ~15) + 4 * (((g & 1) << 1) | (g >> 1)); }
__device__ __forceinline__ bf16x8s pack8(const float (&x)[8]) { v4u w; w.x = cvtpk(x[0], x[1]); w.y = cvtpk(x[2], x[3]); w.z = cvtpk(x[4], x[5]); w.w = cvtpk(x[6], x[7]); return __builtin_bit_cast(bf16x8s, w); }
#define MFMA32(a, b, c) __builtin_amdgcn_mfma_f32_32x32x16_bf16((a), (b), (c), 0, 0, 0)

__device__ __forceinline__ void gdn_chunk_prep(Frame& F, const Args& args) {
    const int gw = F.vcu * NWAVES + F.wave, NGW = F.G * NWAVES;
    LAS float* ALDS = (LAS float*)(F.lds + RING_OFF + F.wave * 16384);
    LAS bf16* TL = (LAS bf16*)ALDS;
    LAS float* GAM = (LAS float*)(F.lds + SM_OFF + F.wave * SM_WAVE);
    LAS float* BET = GAM + 64;
    LAS float* EG = GAM + 128;
    LAS float* EGB = GAM + 192;
    LAS float* KDS = GAM + 256;
    const bf16* QKVC = (const bf16*)(F.ws + WS_QKVC);
    for (int u = gw; u < N_CHUNK_UNITS; u += NGW) {
        int l = F.lane; asm volatile("" : "+v"(l));
        const int r = l & 31, hh = l >> 5;
        const int chain = u >> 6, n = u & 63, b = chain / AH, h = chain % AH, mbase = b * SEQ + 64 * n;
        unsigned char* cb = F.ws + WS_CHK + (size_t)u * CHK_STRIDE;
        {
            const float gl = ((const float*)(F.ws + WS_G))[(size_t)(mbase + l) * AH + h], bl = ((const float*)(F.ws + WS_BETA))[(size_t)(mbase + l) * AH + h];
            float gam = gl;
#pragma unroll
            for (int off = 1; off < 64; off <<= 1) { const float t = __shfl_up(gam, off); if (l >= off) gam += t; }
            const float glast = __shfl(gam, 63);
            const float eg = __expf(gam);
            GAM[l] = gam; BET[l] = bl; EG[l] = eg; EGB[l] = bl * eg; KDS[l] = __expf(glast - gam);
            if (l == 63) ((float*)(F.ws + WS_GT))[u] = eg;
        }
        LDS_WAIT(); asm volatile("" ::: "memory");
        const bf16* qp = QKVC + (size_t)(mbase + r) * 3840 + h * ADK + 8 * hh;
        f32x16 KK00, KK10, KK11, KQ00, KQ01, KQ11;
#pragma unroll
        for (int i = 0; i < 16; ++i) { KK00[i] = 0.f; KK10[i] = 0.f; KK11[i] = 0.f; KQ00[i] = 0.f; KQ01[i] = 0.f; KQ11[i] = 0.f; }
#pragma unroll 2
        for (int s = 0; s < 8; ++s) {
            const bf16x8s kf0 = *(const bf16x8s*)(qp + AW + 16 * s), kf1 = *(const bf16x8s*)(qp + AW + 32 * 3840 + 16 * s);
            const bf16x8s qf0 = *(const bf16x8s*)(qp + 16 * s), qf1 = *(const bf16x8s*)(qp + 32 * 3840 + 16 * s);
            KK00 = MFMA32(kf0, kf0, KK00); KK10 = MFMA32(kf1, kf0, KK10); KK11 = MFMA32(kf1, kf1, KK11);
            KQ00 = MFMA32(kf0, qf0, KQ00); KQ01 = MFMA32(kf0, qf1, KQ01); KQ11 = MFMA32(kf1, qf1, KQ11);
        }
#define GDN_A_TILE(acc, mt, nt) do { const int col = 32 * (nt) + r; const float gamc = GAM[col]; \
            _Pragma("unroll") for (int i4 = 0; i4 < 4; ++i4) { const int rb = 32 * (mt) + 8 * i4 + 4 * hh; const f32x4 gr = *(const LAS f32x4*)(GAM + rb), br = *(const LAS f32x4*)(BET + rb); \
                _Pragma("unroll") for (int e = 0; e < 4; ++e) { const int row = rb + e; ALDS[row * 64 + col] = row > col ? br[e] * acc[4 * i4 + e] * __expf(gr[e] - gamc) : 0.f; } } } while (0)
        GDN_A_TILE(KK00, 0, 0); GDN_A_TILE(KK10, 1, 0); GDN_A_TILE(KK11, 1, 1);
#undef GDN_A_TILE
        {
            bf16* QK = (bf16*)(cb + CHK_QK);
#define GDN_QK_TILE(acc, jt, it, zero) do { const int i_ = 32 * (it) + r; const float gami = GAM[i_]; \
            _Pragma("unroll") for (int i4 = 0; i4 < 4; ++i4) { const int j4 = 32 * (jt) + 8 * i4 + 4 * hh; const f32x4 gj = *(const LAS f32x4*)(GAM + j4); float x[4]; \
                _Pragma("unroll") for (int e = 0; e < 4; ++e) x[e] = (!(zero) && i_ >= j4 + e) ? acc[4 * i4 + e] * __expf(gami - gj[e]) : 0.f; \
                v2u w; w.x = cvtpk(x[0], x[1]); w.y = cvtpk(x[2], x[3]); *(v2u*)(QK + (size_t)i_ * 64 + pos4(j4)) = w; } } while (0)
            GDN_QK_TILE(KQ00, 0, 0, false); GDN_QK_TILE(KQ01, 0, 1, false); GDN_QK_TILE(KQ11, 1, 1, false); GDN_QK_TILE(KQ00, 1, 0, true);
#undef GDN_QK_TILE
        }
        LDS_WAIT(); asm volatile("" ::: "memory");
        float t[64];
#pragma unroll
        for (int i = 0; i < 64; ++i) {
            float s0 = 0.f, s1 = 0.f;
#pragma unroll
            for (int jq = 0; jq < (i + 3) / 4; ++jq) { const f32x4 a = *(const LAS f32x4*)(ALDS + i * 64 + 4 * jq);
#pragma unroll
                for (int e = 0; e < 4; ++e) if (4 * jq + e < i) { if (jq & 1) s1 += a[e] * t[4 * jq + e]; else s0 += a[e] * t[4 * jq + e]; } }
            t[i] = (l == i ? 1.f : 0.f) - (s0 + s1);
        }
        asm volatile("" ::: "memory");
        {
            const int pc = pos4(l & ~3) + (l & 3);
#pragma unroll
            for (int i = 0; i < 64; i += 2) { const unsigned w = cvtpk(t[i], t[i + 1]); TL[i * 72 + pc] = (bf16)(w & 0xffffu); TL[(i + 1) * 72 + pc] = (bf16)(w >> 16); }
        }
        LDS_WAIT(); asm volatile("" ::: "memory");
#define GDN_TFRAG(mt, S4) (*(const LAS bf16x8s*)(TL + (32 * (mt) + r) * 72 + 16 * (S4) + 8 * hh))
        bf16x8s idf[2];
#pragma unroll
        for (int s = 0; s < 2; ++s) { v4u w;
            w.x = (16 * s + 8 * hh + 0 == r ? 0x3F80u : 0u) | (16 * s + 8 * hh + 1 == r ? 0x3F800000u : 0u); w.y = (16 * s + 8 * hh + 2 == r ? 0x3F80u : 0u) | (16 * s + 8 * hh + 3 == r ? 0x3F800000u : 0u);
            w.z = (16 * s + 8 * hh + 4 == r ? 0x3F80u : 0u) | (16 * s + 8 * hh + 5 == r ? 0x3F800000u : 0u); w.w = (16 * s + 8 * hh + 6 == r ? 0x3F80u : 0u) | (16 * s + 8 * hh + 7 == r ? 0x3F800000u : 0u);
            idf[s] = __builtin_bit_cast(bf16x8s, w); }
#pragma unroll 1
        for (int vs = 0; vs < 4; ++vs) {
            bf16x8s bfr[2][2];
#pragma unroll
            for (int tt = 0; tt < 2; ++tt) {
                f32x16 X;
#pragma unroll
                for (int i = 0; i < 16; ++i) X[i] = 0.f;
#pragma unroll
                for (int s = 0; s < 2; ++s) X = MFMA32(*(const bf16x8s*)(qp + 2 * AW + (size_t)tt * 32 * 3840 + 32 * vs + 16 * s), idf[s], X);
#pragma unroll
                for (int s = 0; s < 2; ++s) { const f32x4 b0 = *(const LAS f32x4*)(BET + 32 * tt + 16 * s + 4 * hh), b1 = *(const LAS f32x4*)(BET + 32 * tt + 16 * s + 8 + 4 * hh);
                    const float x[8] = {X[8 * s + 0] * b0[0], X[8 * s + 1] * b0[1], X[8 * s + 2] * b0[2], X[8 * s + 3] * b0[3], X[8 * s + 4] * b1[0], X[8 * s + 5] * b1[1], X[8 * s + 6] * b1[2], X[8 * s + 7] * b1[3]};
                    bfr[tt][s] = pack8(x); }
            }
#pragma unroll
            for (int mt = 0; mt < 2; ++mt) {
                f32x16 U;
#pragma unroll
                for (int i = 0; i < 16; ++i) U[i] = 0.f;
#pragma unroll
                for (int S4 = 0; S4 < 4; ++S4) U = MFMA32(GDN_TFRAG(mt, S4), bfr[S4 >> 1][S4 & 1], U);
#pragma unroll
                for (int q = 0; q < 4; ++q) *(f32x4*)(cb + ((size_t)((vs * 2 + mt) * 4 + q) * 64 + l) * 16) = (f32x4){U[4 * q], U[4 * q + 1], U[4 * q + 2], U[4 * q + 3]};
            }
        }
#pragma unroll 1
        for (int kt = 0; kt < 4; ++kt) {
            bf16x8s afr[2][2];
            bf16* KD = (bf16*)(cb + CHK_KD); bf16* WN = (bf16*)(cb + CHK_WN);
#pragma unroll
            for (int tt = 0; tt < 2; ++tt) {
                f32x16 X;
#pragma unroll
                for (int i = 0; i < 16; ++i) X[i] = 0.f;
#pragma unroll
                for (int s = 0; s < 2; ++s) X = MFMA32(*(const bf16x8s*)(qp + AW + (size_t)tt * 32 * 3840 + 32 * kt + 16 * s), idf[s], X);
#pragma unroll
                for (int i4 = 0; i4 < 4; ++i4) { const int j4 = 32 * tt + 8 * i4 + 4 * hh; const f32x4 kd = *(const LAS f32x4*)(KDS + j4);
                    v2u w; w.x = cvtpk(X[4 * i4] * kd[0], X[4 * i4 + 1] * kd[1]); w.y = cvtpk(X[4 * i4 + 2] * kd[2], X[4 * i4 + 3] * kd[3]);
                    *(v2u*)(KD + (size_t)(32 * kt + r) * 64 + pos4(j4)) = w; }
#pragma unroll
                for (int s = 0; s < 2; ++s) { const f32x4 b0 = *(const LAS f32x4*)(EGB + 32 * tt + 16 * s + 4 * hh), b1 = *(const LAS f32x4*)(EGB + 32 * tt + 16 * s + 8 + 4 * hh);
                    const float x[8] = {X[8 * s + 0] * b0[0], X[8 * s + 1] * b0[1], X[8 * s + 2] * b0[2], X[8 * s + 3] * b0[3], X[8 * s + 4] * b1[0], X[8 * s + 5] * b1[1], X[8 * s + 6] * b1[2], X[8 * s + 7] * b1[3]};
                    afr[tt][s] = pack8(x); }
            }
#pragma unroll
            for (int it = 0; it < 2; ++it) {
                f32x16 WT;
#pragma unroll
                for (int i = 0; i < 16; ++i) WT[i] = 0.f;
#pragma unroll
                for (int S4 = 0; S4 < 4; ++S4) WT = MFMA32(afr[S4 >> 1][S4 & 1], GDN_TFRAG(it, S4), WT);
#pragma unroll
                for (int i4 = 0; i4 < 4; ++i4) { const int k4 = 32 * kt + 8 * i4 + 4 * hh;
                    v2u w; w.x = cvtpk(-WT[4 * i4], -WT[4 * i4 + 1]); w.y = cvtpk(-WT[4 * i4 + 2], -WT[4 * i4 + 3]);
                    *(v2u*)(WN + (size_t)(32 * it + r) * 128 + pos4(k4)) = w; }
            }
        }
#undef GDN_TFRAG
        {
            bf16* QD = (bf16*)(cb + CHK_QD); const int chn = l & 15;
#pragma unroll 4
            for (int itr = 0; itr < 16; ++itr) { const int i = 4 * itr + (l >> 4); const float eg = EG[i];
                const v4u qv = *(const v4u*)(QKVC + (size_t)(mbase + i) * 3840 + h * ADK + 8 * chn);
                v2u lo, hi; lo.x = cvtpk(bf_lo(qv.x) * eg, bf_hi(qv.x) * eg); lo.y = cvtpk(bf_lo(qv.y) * eg, bf_hi(qv.y) * eg); hi.x = cvtpk(bf_lo(qv.z) * eg, bf_hi(qv.z) * eg); hi.y = cvtpk(bf_lo(qv.w) * eg, bf_hi(qv.w) * eg);
                bf16* dst = QD + (size_t)i * 128 + 16 * (chn >> 1) + ((chn & 1) ? 4 : 0);
                *(v2u*)dst = lo; *(v2u*)(dst + 8) = hi; }
        }
        LDS_WAIT(); asm volatile("" ::: "memory");
    }
}

__device__ __forceinline__ void gdn_chunk_scan(Frame& F, const Args& args) {
    if (F.wave != 0) return;
    const int l = F.lane, r = l & 31, hh = l >> 5;
    for (int task = F.vcu; task < NBP * AH * 4; task += F.G) {
        const int chain = task >> 2, vs = task & 3, b = chain / AH, h = chain % AH;
        const unsigned char* cb0 = F.ws + WS_CHK + (size_t)chain * 64 * CHK_STRIDE;
        const float gtv = ((const float*)(F.ws + WS_GT))[chain * 64 + l];
        const unsigned offU = (unsigned)((vs * 8) * 64 + l) * 16u;
        const unsigned offW = (unsigned)CHK_WN + (unsigned)(r * 128 + 8 * hh) * 2u;
        const unsigned offQ = (unsigned)CHK_QD + (unsigned)(r * 128 + 8 * hh) * 2u;
        const unsigned offK = (unsigned)CHK_QK + (unsigned)(r * 64 + 8 * hh) * 2u;
        const unsigned offD = (unsigned)CHK_KD + (unsigned)(r * 64 + 8 * hh) * 2u;
#define GDN_DMA(src, slot, bufb) __builtin_amdgcn_global_load_lds((const unsigned*)(src), (LAS unsigned*)(F.lds + RING_OFF + (bufb) * 65536 + (slot) * 1024), 16, 0, 0)
#define GDN_ISSUE(n_, bufb) do { const unsigned char* cbn = cb0 + (size_t)(n_) * CHK_STRIDE; \
            _Pragma("unroll 1") for (int sl = 0; sl < 8; ++sl) GDN_DMA(cbn + offU + sl * 1024, sl, bufb); \
            _Pragma("unroll 1") for (int j = 0; j < 16; ++j) { GDN_DMA(cbn + offW + (j >> 3) * 8192 + (j & 7) * 32, 8 + j, bufb); GDN_DMA(cbn + offQ + (j >> 3) * 8192 + (j & 7) * 32, 24 + j, bufb); } \
            _Pragma("unroll 1") for (int j = 0; j < 8; ++j) GDN_DMA(cbn + offK + (j >> 2) * 4096 + (j & 3) * 32, 40 + j, bufb); \
            _Pragma("unroll 1") for (int j = 0; j < 16; ++j) GDN_DMA(cbn + offD + (j >> 2) * 4096 + (j & 3) * 32, 48 + j, bufb); } while (0)
        f32x16 Sacc[4];
#pragma unroll
        for (int kt = 0; kt < 4; ++kt)
#pragma unroll
            for (int i = 0; i < 16; ++i) Sacc[kt][i] = 0.f;
        GDN_ISSUE(0, 0);
        float* OA = (float*)(F.ws + WS_OA) + (size_t)(b * SEQ) * AW + h * ADK + 32 * vs + r;
#pragma unroll 1
        for (int n = 0; n < 64; ++n) {
            asm volatile("s_waitcnt vmcnt(0)" ::: "memory");
            if (n + 1 < 64) { const int nb_ = (n + 1) & 1; GDN_ISSUE(n + 1, nb_); }
            __builtin_amdgcn_sched_barrier(0);
            const float gt = __builtin_bit_cast(float, __builtin_amdgcn_readlane(__builtin_bit_cast(int, gtv), n));
            const LAS unsigned char* B = F.lds + RING_OFF + (n & 1) * 65536 + l * 16;
#define GDN_SLOT(sl) (*(const LAS bf16x8s*)(B + (sl) * 1024))
            bf16x8s Sb[4][2];
#pragma unroll
            for (int kt = 0; kt < 4; ++kt)
#pragma unroll
                for (int s = 0; s < 2; ++s) { const float x[8] = {Sacc[kt][8 * s], Sacc[kt][8 * s + 1], Sacc[kt][8 * s + 2], Sacc[kt][8 * s + 3], Sacc[kt][8 * s + 4], Sacc[kt][8 * s + 5], Sacc[kt][8 * s + 6], Sacc[kt][8 * s + 7]}; Sb[kt][s] = pack8(x); }
            f32x16 Up[2];
#pragma unroll
            for (int mt = 0; mt < 2; ++mt)
#pragma unroll
                for (int q = 0; q < 4; ++q) { const f32x4 uq = *(const LAS f32x4*)(B + (mt * 4 + q) * 1024); Up[mt][4 * q] = uq[0]; Up[mt][4 * q + 1] = uq[1]; Up[mt][4 * q + 2] = uq[2]; Up[mt][4 * q + 3] = uq[3]; }
#pragma unroll
            for (int S8 = 0; S8 < 8; ++S8)
#pragma unroll
                for (int mt = 0; mt < 2; ++mt) Up[mt] = MFMA32(GDN_SLOT(8 + mt * 8 + S8), Sb[S8 >> 1][S8 & 1], Up[mt]);
            bf16x8s Ub[2][2];
#pragma unroll
            for (int mt = 0; mt < 2; ++mt)
#pragma unroll
                for (int s = 0; s < 2; ++s) { const float x[8] = {Up[mt][8 * s], Up[mt][8 * s + 1], Up[mt][8 * s + 2], Up[mt][8 * s + 3], Up[mt][8 * s + 4], Up[mt][8 * s + 5], Up[mt][8 * s + 6], Up[mt][8 * s + 7]}; Ub[mt][s] = pack8(x); }
            {
                f32x16 O[2];
#pragma unroll
                for (int mt = 0; mt < 2; ++mt)
#pragma unroll
                    for (int i = 0; i < 16; ++i) O[mt][i] = 0.f;
#pragma unroll
                for (int S8 = 0; S8 < 8; ++S8)
#pragma unroll
                    for (int mt = 0; mt < 2; ++mt) O[mt] = MFMA32(GDN_SLOT(24 + mt * 8 + S8), Sb[S8 >> 1][S8 & 1], O[mt]);
#pragma unroll
                for (int S4 = 0; S4 < 4; ++S4)
#pragma unroll
                    for (int mt = 0; mt < 2; ++mt) if (S4 < 2 * (mt + 1)) O[mt] = MFMA32(GDN_SLOT(40 + mt * 4 + S4), Ub[S4 >> 1][S4 & 1], O[mt]);
#pragma unroll
                for (int mt = 0; mt < 2; ++mt)
#pragma unroll
                    for (int i = 0; i < 16; ++i) OA[(size_t)(64 * n + 32 * mt + (i & 3) + 8 * (i >> 2) + 4 * hh) * AW] = O[mt][i];
            }
#pragma unroll
            for (int kt = 0; kt < 4; ++kt)
#pragma unroll
                for (int i = 0; i < 16; ++i) Sacc[kt][i] *= gt;
#pragma unroll
            for (int S4 = 0; S4 < 4; ++S4)
#pragma unroll
                for (int kt = 0; kt < 4; ++kt) Sacc[kt] = MFMA32(GDN_SLOT(48 + kt * 4 + S4), Ub[S4 >> 1][S4 & 1], Sacc[kt]);
#undef GDN_SLOT
        }
        float* so = F.out + O_PS + (size_t)chain * 16384 + 32 * vs + r;
#pragma unroll
        for (int kt = 0; kt < 4; ++kt)
#pragma unroll
            for (int i = 0; i < 16; ++i) so[(size_t)(32 * kt + (i & 3) + 8 * (i >> 2) + 4 * hh) * 128] = Sacc[kt][i];
        asm volatile("s_waitcnt vmcnt(0)" ::: "memory");
#undef GDN_DMA
#undef GDN_ISSUE
    }
}

__device__ __forceinline__ void mixer0_gate(Frame& F, const Args& args) {
    const int gw = F.vcu * NWAVES + F.wave, NGW = F.G * NWAVES;
    const f32x2 on = *(const f32x2*)((args.in[22]) + 2 * F.lane);
    for (int m = gw; m < MV; m += NGW) {
        bf16* mrow = ((bf16*)(F.ws + WS_MIX)) + (size_t)m * D;
#pragma unroll 2
        for (int h = 0; h < AH; ++h) { const f32x2 o = *(const f32x2*)(((float*)(F.ws + WS_OA)) + (size_t)m * AW + h * ADK + 2 * F.lane);
            const float rs = 1.0f / sqrtf(wave_sum(o.x * o.x + o.y * o.y) * (1.0f / 128.0f) + EPS);
            const unsigned zw = *(const unsigned*)(((bf16*)(F.ws + WS_PROJ)) + (size_t)m * PLD + 3840 + h * ADK + 2 * F.lane); const float z0 = bf_lo(zw), z1 = bf_hi(zw);
            *(unsigned*)(mrow + h * ADK + 2 * F.lane) = pk2(o.x * rs * on.x * (z0 / (1.0f + __expf(-z0))), o.y * rs * on.y * (z1 / (1.0f + __expf(-z1)))); }
#pragma unroll
        for (int hs = 0; hs < HPG; ++hs) { const float l0 = ((float*)(F.ws + WS_LSE))[(size_t)m * 12 + hs], l1 = ((float*)(F.ws + WS_LSE))[(size_t)m * 12 + 4 + hs], l2 = ((float*)(F.ws + WS_LSE))[(size_t)m * 12 + 8 + hs];
            const float mx = fmaxf(fmaxf(l0, l1), l2), e0 = __expf(l0 - mx), e1 = __expf(l1 - mx), e2 = __expf(l2 - mx), rs = 1.0f / (e0 + e1 + e2);
            const float al[3] = {e0 * rs, e1 * rs, e2 * rs};
#pragma unroll
            for (int g = 0; g < 3; ++g) { const int col = (g * HPG + hs) * HD + F.lane; mrow[AW + col] = (bf16)f2bf(((float*)(F.ws + WS_OB))[(size_t)m * BW + col] * al[g]); } }
    }
}
__device__ __forceinline__ void mixer1_conv(Frame& F, const Args& args) {
    const bf16* BG = ((bf16*)(F.ws + WS_PROJ)); const bf16* P = ((bf16*)(F.ws + WS_PROJ)) + (size_t)MP * D;
    const long gt = (long)F.vcu * (NWAVES * 64) + F.tid, NGT = (long)F.G * NWAVES * 64;
    for (long i = gt; i < (long)MV * 256; i += NGT) {
        const int m = (int)(i >> 8), c = (int)(i & 255) * 8;
        const bool smp = m >= MPROMPT; const int t = smp ? ((m - MPROMPT) & 3) : (m & (SEQ - 1)); const int sb = smp ? ((m - MPROMPT) >> 2) : 0;
        float y[8];
#pragma unroll
        for (int e = 0; e < 8; ++e) y[e] = 0.f;
#pragma unroll
        for (int j = 0; j < 3; ++j) { const int tt = t - 2 + j; float pv[8];
            if (tt >= 0) { const v4u w = *(const v4u*)(P + (size_t)(m - t + tt) * D + c); pv[0] = bf_lo(w.x); pv[1] = bf_hi(w.x); pv[2] = bf_lo(w.y); pv[3] = bf_hi(w.y); pv[4] = bf_lo(w.z); pv[5] = bf_hi(w.z); pv[6] = bf_lo(w.w); pv[7] = bf_hi(w.w); }
            else if (smp) { const float* sp = (args.in[9]) + (size_t)(sb * 2 + (2 + tt)) * D + c; const f32x4 a = *(const f32x4*)sp, b = *(const f32x4*)(sp + 4);
                pv[0] = a.x; pv[1] = a.y; pv[2] = a.z; pv[3] = a.w; pv[4] = b.x; pv[5] = b.y; pv[6] = b.z; pv[7] = b.w; }
            else {
#pragma unroll
                for (int e = 0; e < 8; ++e) pv[e] = 0.f; }
            const f32x4 w0 = *(const f32x4*)((args.in[25]) + (size_t)j * D + c), w1 = *(const f32x4*)((args.in[25]) + (size_t)j * D + c + 4);
            y[0] += w0.x * pv[0]; y[1] += w0.y * pv[1]; y[2] += w0.z * pv[2]; y[3] += w0.w * pv[3]; y[4] += w1.x * pv[4]; y[5] += w1.y * pv[5]; y[6] += w1.z * pv[6]; y[7] += w1.w * pv[7]; }
        const v4u bw = *(const v4u*)(BG + (size_t)m * D + c);
        v4u o; o.x = pk2(bf_lo(bw.x) * y[0], bf_hi(bw.x) * y[1]); o.y = pk2(bf_lo(bw.y) * y[2], bf_hi(bw.y) * y[3]); o.z = pk2(bf_lo(bw.z) * y[4], bf_hi(bw.z) * y[5]); o.w = pk2(bf_lo(bw.w) * y[6], bf_hi(bw.w) * y[7]);
        *(v4u*)(((bf16*)(F.ws + WS_MIX)) + (size_t)m * D + c) = o;
    }
    for (long i = gt; i < (long)(NBP + NBS) * 2 * D; i += NGT) { const int c = (int)(i % D), j = (int)((i / D) % 2), s = (int)(i / (2 * D));
        if (s < NBP) F.out[O_PSC + (size_t)(s * 2 + j) * D + c] = bf2f(P[(size_t)(s * SEQ + SEQ - 2 + j) * D + c]);
        else { const int sb = s - NBP; F.out[O_SSC + (size_t)(sb * 2 + j) * D + c] = bf2f(P[(size_t)(MPROMPT + sb * LSMP + 2 + j) * D + c]); } }
}


template <int MODE>
__device__ __forceinline__ void skinny_phase(Frame& F, const bf16* Abase, const bf16* Bt, const int K, const int ntasks, const float* gate, const float scale) {
    LAS float* T = (LAS float*)(F.lds + RING_OFF);
    const int r = F.lane & 31, h = F.lane >> 5, kw = K >> 3, nb = kw >> 6;
    unsigned char* ws = F.ws;
    for (int tsk = F.G - 1 - (int)blockIdx.x; tsk < ntasks; tsk += F.G) {
        int row0, row1;
        if (MODE == 0) { row0 = 256 * (tsk >> 2) + 32 * (tsk & 3); row1 = row0 + 128; }
        else if (MODE == 3 && tsk >= 32) { const int j = tsk - 32; row0 = 256 * (8 + (j >> 2)) + 32 * (j & 3); row1 = row0 + 128; }
        else { row0 = 64 * tsk; row1 = row0 + 32; }
        const bf16* w0 = Bt + (size_t)(row0 + r) * K + F.wave * kw + 8 * h;
        const bf16* w1 = Bt + (size_t)(row1 + r) * K + F.wave * kw + 8 * h;
        const bf16* tk = Abase + (size_t)(MPROMPT + r) * K + F.wave * kw + 8 * h;
        f32x16 acc0, acc1;
#pragma unroll
        for (int i = 0; i < 16; ++i) { acc0[i] = 0.f; acc1[i] = 0.f; }
        bf16x8s ca0[4], ca1[4], cb[4];
#pragma unroll
        for (int s4 = 0; s4 < 4; ++s4) { ca0[s4] = *(const bf16x8s*)(w0 + 16 * s4); ca1[s4] = *(const bf16x8s*)(w1 + 16 * s4); cb[s4] = *(const bf16x8s*)(tk + 16 * s4); }
#pragma unroll 1
        for (int bi = 0; bi < nb; ++bi) {
            bf16x8s na0[4], na1[4], nbb[4];
            const int ko = (bi + 1 < nb) ? (bi + 1) * 64 : bi * 64;
#pragma unroll
            for (int s4 = 0; s4 < 4; ++s4) { na0[s4] = *(const bf16x8s*)(w0 + ko + 16 * s4); na1[s4] = *(const bf16x8s*)(w1 + ko + 16 * s4); nbb[s4] = *(const bf16x8s*)(tk + ko + 16 * s4); }
#pragma unroll
            for (int s4 = 0; s4 < 4; ++s4) { acc0 = __builtin_amdgcn_mfma_f32_32x32x16_bf16(ca0[s4], cb[s4], acc0, 0, 0, 0); acc1 = __builtin_amdgcn_mfma_f32_32x32x16_bf16(ca1[s4], cb[s4], acc1, 0, 0, 0); }
#pragma unroll
            for (int s4 = 0; s4 < 4; ++s4) { ca0[s4] = na0[s4]; ca1[s4] = na1[s4]; cb[s4] = nbb[s4]; }
        }
        __syncthreads();
#pragma unroll
        for (int i = 0; i < 16; ++i) { const int n = (i & 3) + 8 * (i >> 2) + 4 * h;
            T[((F.wave * 2 + 0) * 32 + n) * 32 + r] = acc0[i]; T[((F.wave * 2 + 1) * 32 + n) * 32 + r] = acc1[i]; }
        __syncthreads();
        const int tok = F.tid & 31, n0 = 2 * (F.tid >> 5), row = MPROMPT + tok;
        float v[2][2];
#pragma unroll
        for (int t = 0; t < 2; ++t)
#pragma unroll
            for (int e = 0; e < 2; ++e) { float a = 0.f;
#pragma unroll
                for (int w = 0; w < 8; ++w) a += T[((w * 2 + t) * 32 + n0 + e) * 32 + tok];
                v[t][e] = a; }
        if (MODE == 0) { const int ocol = (row0 >> 8) * 128 + (row0 & 127) + n0;
            *(unsigned*)((bf16*)(ws + WS_ACT) + (size_t)row * FF + ocol) = pk2(pg8::silu_f(v[0][0]) * v[1][0], pg8::silu_f(v[0][1]) * v[1][1]); }
        else if (MODE == 1) { const int seq = pg8::seq_of_row(row);
#pragma unroll
            for (int t = 0; t < 2; ++t) { const int col = (t ? row1 : row0) + n0; float* xp = (float*)(ws + WS_X) + (size_t)row * D + col; const float* gp = gate + (size_t)seq * NMOD + col;
                f32x2 xv = *(f32x2*)xp; const f32x2 gv = *(const f32x2*)gp; xv.x += scale * gv.x * v[t][0]; xv.y += scale * gv.y * v[t][1]; *(f32x2*)xp = xv; } }
        else if (MODE == 2) {
            if (row0 < PLD) {
#pragma unroll
                for (int t = 0; t < 2; ++t) *(unsigned*)((bf16*)(ws + WS_PROJ) + (size_t)row * PLD + (t ? row1 : row0) + n0) = pk2(v[t][0], v[t][1]); }
            else { *(f32x2*)((float*)(ws + WS_AB) + (size_t)row * 32 + n0) = (f32x2){v[0][0], v[0][1]}; } }
        else {
            if (row0 < D) {
#pragma unroll
                for (int t = 0; t < 2; ++t) *(unsigned*)((bf16*)(ws + WS_PROJ) + (size_t)row * D + (t ? row1 : row0) + n0) = pk2(v[t][0], v[t][1]); }
            else { const int pcol = ((row0 >> 8) - 8) * 128 + (row0 & 127) + n0;
                *(unsigned*)((bf16*)(ws + WS_PROJ) + (size_t)MP * D + (size_t)row * D + pcol) = pk2(v[0][0] * v[1][0], v[0][1] * v[1][1]); } }
    }
    __syncthreads();
}

#define IN_PH() (lo <= pid && pid < hi)
#define SEAM() do { if (MK_N_LAUNCHES == 1 && lo <= pid && pid + 1 < hi) xcd_barrier(bar); ++pid; } while (0)
template <int L, int SUB>
__device__ __forceinline__ void sublayer(Frame& F, const Args& args, const XcdBarrier& bar, int& pid, const int lo, const int hi) {
    unsigned char* ws = F.ws;
    const float* modl = (const float*)(ws + WS_MOD) + (size_t)L * NSEQ * NMOD;
    if (IN_PH()) { const float* gain = args.in[SUB == 0 ? 12 : (SUB == 1 ? 13 : 14)] + (size_t)L * D;
        norm_phase(F, args, gain, modl + (size_t)(3 * SUB) * D, modl + (size_t)(3 * SUB + 1) * D, L == 0 && SUB == 0); }
    SEAM();
    if constexpr (SUB != 1) {
        constexpr int f = SUB >> 1;
        if (IN_PH()) { pg8::Gemm g{(const pg8::bf16_t*)(ws + WS_H), (const pg8::bf16_t*)(ws + WS_WUP + (size_t)(L * 2 + f) * WUP_STRIDE), MPROMPT, NUP, D}; pg8::StaticOrder S; S.init(MPROMPT, NUP, F.G, (int)blockIdx.x);
            pg8::EpiSwiglu E{(pg8::bf16_t*)(ws + WS_ACT), FF};
            pg8::gemm_phase<pg8::EpiSwiglu, pg8::StaticOrder, true, true>(F.lds + RING_OFF, g, S, E);
            skinny_phase<0>(F, (const bf16*)(ws + WS_H), (const bf16*)(ws + WS_WUP + (size_t)(L * 2 + f) * WUP_STRIDE), D, 176, nullptr, 0.f); }
        SEAM();
        if (IN_PH()) { pg8::Gemm g{(const pg8::bf16_t*)(ws + WS_ACT), (const pg8::bf16_t*)(ws + WS_WDN + (size_t)(L * 2 + f) * WDN_STRIDE), MPROMPT, D, FF}; pg8::StaticOrder S; S.init(MPROMPT, D, F.G, (int)blockIdx.x);
            pg8::EpiResid E{(float*)(ws + WS_X), modl + (size_t)(3 * SUB + 2) * D, 0.5f};
            pg8::gemm_phase<pg8::EpiResid, pg8::StaticOrder, true, true>(F.lds + RING_OFF, g, S, E);
            skinny_phase<1>(F, (const bf16*)(ws + WS_ACT), (const bf16*)(ws + WS_WDN + (size_t)(L * 2 + f) * WDN_STRIDE), FF, 32, modl + (size_t)(3 * SUB + 2) * D, 0.5f); }
        SEAM();
    } else {
        if constexpr (L == 0) {
            if (IN_PH()) { pg8::Gemm g{(const pg8::bf16_t*)(ws + WS_H), (const pg8::bf16_t*)(ws + WS_WIN0), MPROMPT, IN0P, D}; pg8::StaticOrder S; S.init(MPROMPT, IN0P, F.G, (int)blockIdx.x);
                pg8::EpiIn0 E{(pg8::bf16_t*)(ws + WS_PROJ), PLD, (float*)(ws + WS_AB)};
                pg8::gemm_phase<pg8::EpiIn0, pg8::StaticOrder, true, true>(F.lds + RING_OFF, g, S, E);
                skinny_phase<2>(F, (const bf16*)(ws + WS_H), (const bf16*)(ws + WS_WIN0), D, 117, nullptr, 0.f); }
            SEAM();
            if (IN_PH()) { gdn_prep(F, args); swa_prompt(F, args); swa_sample(F, args); mixer0_copies(F, args); }
            SEAM();
            if (IN_PH()) { gdn_chunk_prep(F, args); }
            SEAM();
            if (IN_PH()) { gdn_chunk_scan(F, args); __syncthreads(); gdn_scan_naive(F, args); }
            SEAM();
            if (IN_PH()) { mixer0_gate(F, args); }
            SEAM();
        } else {
            if (IN_PH()) { pg8::Gemm g{(const pg8::bf16_t*)(ws + WS_H), (const pg8::bf16_t*)(ws + WS_WIN1), MPROMPT, IN1, D}; pg8::StaticOrder S; S.init(MPROMPT, IN1, F.G, (int)blockIdx.x);
                pg8::EpiIn1 E{(pg8::bf16_t*)(ws + WS_PROJ), (pg8::bf16_t*)(ws + WS_PROJ) + (size_t)MP * D};
                pg8::gemm_phase<pg8::EpiIn1, pg8::StaticOrder, true, true>(F.lds + RING_OFF, g, S, E);
                skinny_phase<3>(F, (const bf16*)(ws + WS_H), (const bf16*)(ws + WS_WIN1), D, 96, nullptr, 0.f); }
            SEAM();
            if (IN_PH()) { mixer1_conv(F, args); }
            SEAM();
        }
        if (IN_PH()) { pg8::Gemm g{(const pg8::bf16_t*)(ws + WS_MIX), (const pg8::bf16_t*)(ws + (L == 0 ? WS_WOUT0 : WS_WOUT1)), MPROMPT, D, D}; pg8::StaticOrder S; S.init(MPROMPT, D, F.G, (int)blockIdx.x);
            pg8::EpiResid E{(float*)(ws + WS_X), modl + (size_t)(3 * SUB + 2) * D, 1.0f};
            pg8::gemm_phase<pg8::EpiResid, pg8::StaticOrder, true, true>(F.lds + RING_OFF, g, S, E);
            skinny_phase<1>(F, (const bf16*)(ws + WS_MIX), (const bf16*)(ws + (L == 0 ? WS_WOUT0 : WS_WOUT1)), D, 32, modl + (size_t)(3 * SUB + 2) * D, 1.0f); }
        SEAM();
    }
}

__global__ void __launch_bounds__(NWAVES * 64, 2) fwd(Args args) {
    extern __shared__ __attribute__((aligned(16))) unsigned char lds[];
    Frame F;
    F.lds = (LAS unsigned char*)lds;
    F.MISC = (volatile LAS unsigned*)(F.lds + MISC_OFF);
    F.tid = threadIdx.x; F.lane = F.tid & 63; F.wave = __builtin_amdgcn_readfirstlane(F.tid >> 6);
    F.G = gridDim.x; { const int bx = blockIdx.x; F.vcu = (F.G % 8 == 0) ? (bx % 8) * (F.G / 8) + bx / 8 : bx; }
    F.ws = args.ws; F.out = args.out;
    F.ctl = (gu32*)(args.ws + WS_CTL);
    for (int u = F.tid; u < (LDS_BYTES - LDSCTL_OFF) / 4; u += NWAVES * 64) ((LAS unsigned*)(F.lds + LDSCTL_OFF))[u] = 0u;
    __syncthreads();
    XcdBarrier bar; bar.bar = (unsigned*)(F.ctl + CW_BAR); bar.x = 0; bar.st = nullptr;
    if (MK_N_LAUNCHES == 1) bar = xcd_barrier_post((unsigned*)(F.ctl + CW_BAR), F.MISC + 8);

    const int lo = args.ph_lo, hi = args.ph_hi;
    int pid = 0;
    if (IN_PH()) { p0_weights(F, args); p0_mod(F, args); }
    SEAM();
    sublayer<0, 0>(F, args, bar, pid, lo, hi);
    sublayer<0, 1>(F, args, bar, pid, lo, hi);
    sublayer<0, 2>(F, args, bar, pid, lo, hi);
    sublayer<1, 0>(F, args, bar, pid, lo, hi);
    sublayer<1, 1>(F, args, bar, pid, lo, hi);
    sublayer<1, 2>(F, args, bar, pid, lo, hi);
    if (IN_PH()) { final_norm_phase(F, args); }
}
#undef IN_PH
#undef SEAM
constexpr int N_PHASES = 1 + (3 + 3 + 4 + 3) + (3 + 3 + 3 + 1) + 1;

extern "C" void kernel_launch(void* const* d_in, const int* in_sizes, int n_in, void* d_out, int out_size, void* d_ws, size_t ws_size, hipStream_t stream) {
    static int grid = 0;
    if (grid == 0) {
        if (n_in != 27 || out_size != (int)O_END || ws_size < WS_END) { fprintf(stderr, "kernel_launch: expected 27 inputs, %zu outputs, >= %zu B workspace; got %d, %d, %zu\n", (size_t)O_END, (size_t)WS_END, n_in, out_size, ws_size); grid = -1; return; }
        int dev = 0, cus = 0, per_cu = 0;
        if (hipGetDevice(&dev) != hipSuccess || hipDeviceGetAttribute(&cus, hipDeviceAttributeMultiprocessorCount, dev) != hipSuccess) { fprintf(stderr, "kernel_launch: device query failed\n"); grid = -1; return; }
        if (hipFuncSetAttribute((const void*)fwd, hipFuncAttributeMaxDynamicSharedMemorySize, LDS_BYTES) != hipSuccess) { fprintf(stderr, "kernel_launch: hipFuncSetAttribute failed\n"); grid = -1; return; }
        if (hipOccupancyMaxActiveBlocksPerMultiprocessor(&per_cu, (const void*)fwd, NWAVES * 64, LDS_BYTES) != hipSuccess || per_cu < 1)
            fprintf(stderr, "kernel_launch: note: occupancy query reports %d workgroups per CU\n", per_cu);
        (void)hipGetLastError();
        grid = cus;
    }
    if (grid < 0) return;
    if (hipMemsetAsync((char*)d_ws + WS_CTL, 0, CTL_ZERO_BYTES, stream) != hipSuccess) { fprintf(stderr, "kernel_launch: memset failed\n"); return; }
    Args a{};
    for (int i = 0; i < 27; ++i) a.in[i] = (const float*)d_in[i];
    a.out = (float*)d_out; a.ws = (unsigned char*)d_ws;
    if (MK_N_LAUNCHES == 1) {
        a.ph_lo = 0; a.ph_hi = N_PHASES;
        hipLaunchKernelGGL(fwd, dim3(grid), dim3(NWAVES * 64), LDS_BYTES, stream, a);
    } else {
        for (int p = 0; p < N_PHASES; ++p) { a.ph_lo = p; a.ph_hi = p + 1; hipLaunchKernelGGL(fwd, dim3(grid), dim3(NWAVES * 64), LDS_BYTES, stream, a); }
    }
    const hipError_t le = hipPeekAtLastError();
    if (le != hipSuccess) fprintf(stderr, "kernel_launch: launch failed: %s\n", hipGetErrorName(le));
}
```

```cpp
#include <hip/hip_runtime.h>
#include <cstdio>
#include <cstdint>

#ifndef MK_N_LAUNCHES
#define MK_N_LAUNCHES 1
#endif

namespace pg8 {
#define PG8_LAS __attribute__((address_space(3)))
typedef unsigned short bf16_t;
typedef short bf16x8 __attribute__((ext_vector_type(8)));
typedef float f32x4 __attribute__((ext_vector_type(4)));
typedef unsigned u32x4 __attribute__((ext_vector_type(4)));
constexpr int BM = 256, BK = 64, HALF = 128, HTB = HALF * BK * 2, STAGE_BYTES = 8 * HTB, NXCD = 8, WGM = 8;

__host__ __device__ __forceinline__ int lds_byte(int r, int c) { const int st = (r >> 4) * 2 + (c >> 5), rr = r & 15, cc = c & 31, ob = rr * 64 + cc * 2; return st * 1024 + (ob ^ (((ob >> 9) & 1) << 5)); }
__host__ __device__ __forceinline__ void stage_rc(int b, int& R, int& C) { const int st = b / 1024, sb = b % 1024, swz = sb ^ (((sb >> 9) & 1) << 5); R = (st >> 1) * 16 + swz / 64; C = (st & 1) * 32 + (swz % 64) / 2; }
__host__ __device__ __forceinline__ int perm32(int rho) { const int n = rho >> 4, i = rho & 15; return 8 * (i >> 2) + 4 * n + (i & 3); }

struct Unit { int pm, pn; };
struct Gemm { const bf16_t* A; const bf16_t* Bt; int M, N, K; };

struct StaticOrder {
    int nM, nN, nwg, G, c;
    __host__ __device__ void init(int M, int N, int G_, int c_) { nM = M / BM; nN = N / BM; nwg = nM * nN; G = G_; c = c_; }
    __host__ __device__ bool next(int i, Unit& u) const {
        const long L = (long)i * G + c; if (L >= nwg) return false;
        int wgid = (int)L; { const int q = nwg / NXCD, r = nwg % NXCD, xcd = wgid % NXCD, off = wgid / NXCD; wgid = (xcd < r ? xcd * (q + 1) : r * (q + 1) + (xcd - r) * q) + off; }
        const int nig = WGM * nN, gid = wgid / nig, fm = gid * WGM, gsz = (nM - fm) < WGM ? (nM - fm) : WGM;
        u.pm = fm + ((wgid % nig) % gsz); u.pn = (wgid % nig) / gsz; return true;
    }
    __device__ __forceinline__ void a_ready(const Unit&) const {}
    __device__ __forceinline__ void done(const Unit&) const {}
};

__device__ __forceinline__ unsigned cvt_pk_bf16(float lo, float hi) { unsigned r; asm volatile("v_cvt_pk_bf16_f32 %0, %1, %2" : "=v"(r) : "v"(lo), "v"(hi)); return r; }
__device__ __forceinline__ float silu_f(float x) { return x * __builtin_amdgcn_rcpf(1.0f + __expf(-x)); }

constexpr int E_MV = 8224, E_MPROMPT = 8192, E_D = 2048, E_NMOD = 18432;
__device__ __forceinline__ int seq_of_row(int r) { return r < E_MPROMPT ? (r >> 12) : 2 + ((r - E_MPROMPT) >> 2); }

struct EpiSwiglu {
    static constexpr bool PERM = true, AFTER_DRAIN = false;
    bf16_t* O; int ldc;
    __device__ __forceinline__ void operator()(const f32x4 (&acc)[2][2][4][2], const Unit& u, int wr, int wc, int fr, int fq) const {
        const int row0 = u.pm * BM + wr * 64 + fr, col0 = u.pn * HALF + wc * 32 + 8 * fq;
#pragma unroll
        for (int ai = 0; ai < 2; ++ai)
#pragma unroll
            for (int m = 0; m < 4; ++m) { bf16_t* rowp = O + (size_t)(row0 + ai * HALF + m * 16) * ldc + col0;
                const f32x4 g0 = acc[ai][0][m][0], g1 = acc[ai][0][m][1], u0 = acc[ai][1][m][0], u1 = acc[ai][1][m][1];
                u32x4 w; w.x = cvt_pk_bf16(silu_f(g0[0]) * u0[0], silu_f(g0[1]) * u0[1]); w.y = cvt_pk_bf16(silu_f(g0[2]) * u0[2], silu_f(g0[3]) * u0[3]);
                w.z = cvt_pk_bf16(silu_f(g1[0]) * u1[0], silu_f(g1[1]) * u1[1]); w.w = cvt_pk_bf16(silu_f(g1[2]) * u1[2], silu_f(g1[3]) * u1[3]);
                *(u32x4*)rowp = w; }
    }
};
struct EpiResid {
    static constexpr bool PERM = false, AFTER_DRAIN = false;
    float* X; const float* gate; float scale;
    __device__ __forceinline__ void operator()(const f32x4 (&acc)[2][2][4][2], const Unit& u, int wr, int wc, int fr, int fq) const {
        const int col0 = u.pn * BM + wc * 32 + 4 * fq;
#pragma unroll
        for (int ai = 0; ai < 2; ++ai)
#pragma unroll
            for (int m = 0; m < 4; ++m) { const int r = u.pm * BM + ai * HALF + wr * 64 + m * 16 + fr;
                if (r < E_MV) { const float* gp = gate + (size_t)seq_of_row(r) * E_NMOD + col0; float* xp = X + (size_t)r * E_D + col0;
#pragma unroll
                    for (int bj = 0; bj < 2; ++bj)
#pragma unroll
                        for (int n = 0; n < 2; ++n) { const f32x4 gv = *(const f32x4*)(gp + bj * HALF + n * 16); f32x4 xv = *(const f32x4*)(xp + bj * HALF + n * 16);
                            xv = xv + (gv * scale) * acc[ai][bj][m][n]; *(f32x4*)(xp + bj * HALF + n * 16) = xv; } }
                if (m & 1) asm volatile("" ::: "memory"); }
    }
};
struct EpiIn0 {
    static constexpr bool PERM = true, AFTER_DRAIN = false;
    bf16_t* O; int ldc; float* AB;
    __device__ __forceinline__ void operator()(const f32x4 (&acc)[2][2][4][2], const Unit& u, int wr, int wc, int fr, int fq) const {
        const int row0 = u.pm * BM + wr * 64 + fr;
        if (u.pn < 29) { const int col0 = u.pn * BM + wc * 32 + 8 * fq;
#pragma unroll
            for (int ai = 0; ai < 2; ++ai)
#pragma unroll
                for (int m = 0; m < 4; ++m) { bf16_t* rowp = O + (size_t)(row0 + ai * HALF + m * 16) * ldc + col0;
#pragma unroll
                    for (int bj = 0; bj < 2; ++bj) { const f32x4 v0 = acc[ai][bj][m][0], v1 = acc[ai][bj][m][1];
                        u32x4 w; w.x = cvt_pk_bf16(v0[0], v0[1]); w.y = cvt_pk_bf16(v0[2], v0[3]); w.z = cvt_pk_bf16(v1[0], v1[1]); w.w = cvt_pk_bf16(v1[2], v1[3]);
                        *(u32x4*)(rowp + bj * HALF) = w; } }
        } else if (wc == 0) {
#pragma unroll
            for (int ai = 0; ai < 2; ++ai)
#pragma unroll
                for (int m = 0; m < 4; ++m) { float* rowp = AB + (size_t)(row0 + ai * HALF + m * 16) * 32 + 8 * fq;
                    *(f32x4*)rowp = acc[ai][0][m][0]; *(f32x4*)(rowp + 4) = acc[ai][0][m][1]; }
        }
    }
};
struct EpiIn1 {
    static constexpr bool PERM = true, AFTER_DRAIN = false;
    bf16_t* BG; bf16_t* P;
    __device__ __forceinline__ void operator()(const f32x4 (&acc)[2][2][4][2], const Unit& u, int wr, int wc, int fr, int fq) const {
        const int row0 = u.pm * BM + wr * 64 + fr;
        if (u.pn < 8) { const int col0 = u.pn * BM + wc * 32 + 8 * fq;
#pragma unroll
            for (int ai = 0; ai < 2; ++ai)
#pragma unroll
                for (int m = 0; m < 4; ++m) { bf16_t* rowp = BG + (size_t)(row0 + ai * HALF + m * 16) * E_D + col0;
#pragma unroll
                    for (int bj = 0; bj < 2; ++bj) { const f32x4 v0 = acc[ai][bj][m][0], v1 = acc[ai][bj][m][1];
                        u32x4 w; w.x = cvt_pk_bf16(v0[0], v0[1]); w.y = cvt_pk_bf16(v0[2], v0[3]); w.z = cvt_pk_bf16(v1[0], v1[1]); w.w = cvt_pk_bf16(v1[2], v1[3]);
                        *(u32x4*)(rowp + bj * HALF) = w; } }
        } else { const int col0 = (u.pn - 8) * HALF + wc * 32 + 8 * fq;
#pragma unroll
            for (int ai = 0; ai < 2; ++ai)
#pragma unroll
                for (int m = 0; m < 4; ++m) { bf16_t* rowp = P + (size_t)(row0 + ai * HALF + m * 16) * E_D + col0;
                    const f32x4 a0 = acc[ai][0][m][0], a1 = acc[ai][0][m][1], b0 = acc[ai][1][m][0], b1 = acc[ai][1][m][1];
                    u32x4 w; w.x = cvt_pk_bf16(a0[0] * b0[0], a0[1] * b0[1]); w.y = cvt_pk_bf16(a0[2] * b0[2], a0[3] * b0[3]);
                    w.z = cvt_pk_bf16(a1[0] * b1[0], a1[1] * b1[1]); w.w = cvt_pk_bf16(a1[2] * b1[2], a1[3] * b1[3]);
                    *(u32x4*)rowp = w; }
        }
    }
};

template <class Epi, class Sched, bool ALIGN_EPI = false, bool SP2 = false>
__device__ __forceinline__ void gemm_phase(PG8_LAS unsigned char* lds, const Gemm g, const Sched& S, const Epi& E) {
    const int tid = threadIdx.x, wid = __builtin_amdgcn_readfirstlane(tid >> 6), lane = tid & 63, wr = wid >> 2, wc = wid & 3, fr = lane & 15, fq = lane >> 4;
    const int K = g.K, nt = K / BK;
    unsigned voffA[2], voffB[2];
#pragma unroll
    for (int i = 0; i < 2; ++i) { int R, C; stage_rc(tid * 16 + i * 8192, R, C); const int Rb = Epi::PERM ? ((R & ~31) + perm32(R & 31)) : R;
        voffA[i] = (unsigned)(R * K + C) * 2u; voffB[i] = (unsigned)(Rb * K + C) * 2u; }
    const size_t kstep = (size_t)(BK * 2);
    const size_t hstep = (size_t)HALF * K * 2;
    const size_t tstep = 2 * hstep;
    const unsigned ldsw = (unsigned)wid * 1024u;
    const int aoff = lds_byte(wr * 64 + fr, fq * 8), boff = lds_byte(wc * 32 + fr, fq * 8);
#define PG8_SA(b, h) (((b) * 2 + (h)) * HTB)
#define PG8_SB(b, h) ((4 + (b) * 2 + (h)) * HTB)
#define PG8_STAGE(bufoff, gbase, voff) do { _Pragma("unroll") for (int _i = 0; _i < 2; ++_i) \
        __builtin_amdgcn_global_load_lds((const unsigned*)((const char*)(gbase) + (voff)[_i]), (PG8_LAS unsigned*)(lds + (bufoff) + ldsw + _i * 8192), 16, 0, 0); } while (0)
#define PG8_LDA(dst, b, h) do { _Pragma("unroll") for (int m = 0; m < 4; ++m) _Pragma("unroll") for (int k = 0; k < 2; ++k) dst[m][k] = *(const PG8_LAS bf16x8*)(lds + PG8_SA(b, h) + aoff + m * 2048 + k * 1024); } while (0)
#define PG8_LDB(dst, b, h) do { _Pragma("unroll") for (int n = 0; n < 2; ++n) _Pragma("unroll") for (int k = 0; k < 2; ++k) dst[n][k] = *(const PG8_LAS bf16x8*)(lds + PG8_SB(b, h) + boff + n * 2048 + k * 1024); } while (0)
#define PG8_MMA(ai, bj, At, Bt) do { __builtin_amdgcn_s_setprio(1); _Pragma("unroll") for (int m = 0; m < 4; ++m) _Pragma("unroll") for (int n = 0; n < 2; ++n) _Pragma("unroll") for (int k = 0; k < 2; ++k) \
        acc[ai][bj][m][n] = __builtin_amdgcn_mfma_f32_16x16x32_bf16(Bt[n][k], At[m][k], acc[ai][bj][m][n], 0, 0, 0); __builtin_amdgcn_s_setprio(0); } while (0)
#define PG8_WAIT_V(n) asm volatile("s_waitcnt vmcnt(" #n ")" ::: "memory")
#define PG8_WAIT_L(n) asm volatile("s_waitcnt lgkmcnt(" #n ")" ::: "memory")
#define PG8_BAR __builtin_amdgcn_s_barrier()
#define PG8_SCHED __builtin_amdgcn_sched_barrier(0)
    Unit cur, nxt; int ui = 0;
    if (!S.next(0, cur)) return;
    f32x4 acc[2][2][4][2];
#pragma unroll
    for (int a = 0; a < 2; ++a)
#pragma unroll
        for (int b = 0; b < 2; ++b)
#pragma unroll
            for (int m = 0; m < 4; ++m)
#pragma unroll
                for (int n = 0; n < 2; ++n) acc[a][b][m][n] = (f32x4){0.f, 0.f, 0.f, 0.f};
    bf16x8 At[4][2], B0[2][2], B1[2][2];
    const char* cA = (const char*)g.A + (size_t)cur.pm * tstep; const char* cB = (const char*)g.Bt + (size_t)cur.pn * tstep;
    S.a_ready(cur);
    if constexpr (SP2) {
        PG8_STAGE(PG8_SB(0, 0), cB, voffB); PG8_STAGE(PG8_SB(0, 1), cB + hstep, voffB); PG8_STAGE(PG8_SA(0, 0), cA, voffA); PG8_STAGE(PG8_SA(0, 1), cA + hstep, voffA);
        if (wr == 1) PG8_BAR;
        PG8_WAIT_V(2); PG8_BAR;
        PG8_STAGE(PG8_SB(1, 0), cB + kstep, voffB); PG8_STAGE(PG8_SA(1, 0), cA + kstep, voffA); PG8_STAGE(PG8_SB(1, 1), cB + hstep + kstep, voffB);
        PG8_WAIT_V(6); PG8_BAR;
    } else {
        PG8_STAGE(PG8_SB(0, 0), cB, voffB); PG8_STAGE(PG8_SA(0, 0), cA, voffA); PG8_STAGE(PG8_SB(0, 1), cB + hstep, voffB); PG8_STAGE(PG8_SA(0, 1), cA + hstep, voffA);
        if (wr == 1) PG8_BAR;
        PG8_WAIT_V(4); PG8_BAR;
        PG8_STAGE(PG8_SB(1, 0), cB + kstep, voffB); PG8_STAGE(PG8_SA(1, 0), cA + kstep, voffA); PG8_STAGE(PG8_SB(1, 1), cB + hstep + kstep, voffB);
        PG8_WAIT_V(6); PG8_BAR;
    }
    for (;;) {
        const bool has_next = S.next(ui + 1, nxt);
        const char* nA = has_next ? (const char*)g.A + (size_t)nxt.pm * tstep : cA; const char* nB = has_next ? (const char*)g.Bt + (size_t)nxt.pn * tstep : cB;
        for (int t = 0; t < nt; t += 2) {
            const bool last = (t == nt - 2);
            const char* a1 = cA + (size_t)(t + 1) * kstep;
            const char* a2 = last ? nA : cA + (size_t)(t + 2) * kstep; const char* b2 = last ? nB : cB + (size_t)(t + 2) * kstep;
            const char* a3 = a2 + kstep; const char* b3 = b2 + kstep;
            if (last && has_next) S.a_ready(nxt);
            if constexpr (SP2) {
            PG8_LDB(B0, 0, 0); PG8_LDB(B1, 0, 1); PG8_SCHED; PG8_LDA(At, 0, 0); PG8_STAGE(PG8_SA(1, 1), a1 + hstep, voffA);
            PG8_WAIT_V(8); PG8_WAIT_L(0); PG8_BAR; PG8_MMA(0, 0, At, B0); PG8_MMA(0, 1, At, B1); PG8_BAR; PG8_SCHED;
            PG8_LDA(At, 0, 1); PG8_STAGE(PG8_SB(0, 0), b2, voffB); PG8_STAGE(PG8_SB(0, 1), b2 + hstep, voffB); PG8_STAGE(PG8_SA(0, 0), a2, voffA);
            PG8_WAIT_V(8); PG8_WAIT_L(0); PG8_BAR; PG8_MMA(1, 0, At, B0); PG8_MMA(1, 1, At, B1); PG8_BAR; PG8_SCHED;
            PG8_LDB(B0, 1, 0); PG8_LDB(B1, 1, 1); PG8_SCHED; PG8_LDA(At, 1, 0); PG8_STAGE(PG8_SA(0, 1), a2 + hstep, voffA);
            PG8_WAIT_V(8); PG8_WAIT_L(0); PG8_BAR; PG8_MMA(0, 0, At, B0); PG8_MMA(0, 1, At, B1); PG8_BAR; PG8_SCHED;
            PG8_LDA(At, 1, 1); PG8_STAGE(PG8_SB(1, 0), b3, voffB); PG8_STAGE(PG8_SB(1, 1), b3 + hstep, voffB); PG8_STAGE(PG8_SA(1, 0), a3, voffA);
            PG8_WAIT_V(8); PG8_WAIT_L(0); PG8_BAR; PG8_MMA(1, 0, At, B0); PG8_MMA(1, 1, At, B1); PG8_BAR; PG8_SCHED;
            } else {
            PG8_LDB(B0, 0, 0); PG8_SCHED; PG8_LDA(At, 0, 0); PG8_STAGE(PG8_SA(1, 1), a1 + hstep, voffA);
            PG8_WAIT_L(8); PG8_BAR; PG8_WAIT_L(0); PG8_MMA(0, 0, At, B0); PG8_BAR; PG8_SCHED;
            PG8_LDB(B1, 0, 1); PG8_STAGE(PG8_SB(0, 0), b2, voffB);
            PG8_BAR; PG8_WAIT_L(0); PG8_MMA(0, 1, At, B1); PG8_BAR;
            PG8_LDA(At, 0, 1); PG8_STAGE(PG8_SA(0, 0), a2, voffA);
            PG8_BAR; PG8_WAIT_L(0); PG8_MMA(1, 0, At, B0); PG8_BAR; PG8_SCHED;
            PG8_STAGE(PG8_SB(0, 1), b2 + hstep, voffB);
            PG8_WAIT_V(6); PG8_BAR; PG8_MMA(1, 1, At, B1); PG8_BAR;
            PG8_LDB(B0, 1, 0); PG8_SCHED; PG8_LDA(At, 1, 0); PG8_STAGE(PG8_SA(0, 1), a2 + hstep, voffA);
            PG8_WAIT_L(8); PG8_BAR; PG8_WAIT_L(0); PG8_MMA(0, 0, At, B0); PG8_BAR; PG8_SCHED;
            PG8_LDB(B1, 1, 1); PG8_STAGE(PG8_SB(1, 0), b3, voffB);
            PG8_BAR; PG8_WAIT_L(0); PG8_MMA(0, 1, At, B1); PG8_BAR;
            PG8_LDA(At, 1, 1); PG8_STAGE(PG8_SA(1, 0), a3, voffA);
            PG8_BAR; PG8_WAIT_L(0); PG8_MMA(1, 0, At, B0); PG8_BAR; PG8_SCHED;
            PG8_STAGE(PG8_SB(1, 1), b3 + hstep, voffB);
            PG8_WAIT_V(6); PG8_BAR; PG8_MMA(1, 1, At, B1); PG8_BAR;
            }
        }
        if constexpr (ALIGN_EPI) { if (wr == 0) PG8_BAR; }
        if constexpr (!Epi::AFTER_DRAIN) { E(acc, cur, wr, wc, fr, fq); S.done(cur); }
        if (!has_next) break;
#pragma unroll
        for (int a = 0; a < 2; ++a)
#pragma unroll
            for (int b = 0; b < 2; ++b)
#pragma unroll
                for (int m = 0; m < 4; ++m)
#pragma unroll
                    for (int n = 0; n < 2; ++n) acc[a][b][m][n] = (f32x4){0.f, 0.f, 0.f, 0.f};
        cur = nxt; cA = nA; cB = nB; ++ui;
        if constexpr (ALIGN_EPI) { if (wr == 1) PG8_BAR; }
    }
    PG8_WAIT_V(0);
    if constexpr (!ALIGN_EPI) { if (wr == 0) PG8_BAR; }
    PG8_BAR;
#undef PG8_SA
#undef PG8_SB
#undef PG8_STAGE
#undef PG8_LDA
#undef PG8_LDB
#undef PG8_MMA
#undef PG8_WAIT_V
#undef PG8_WAIT_L
#undef PG8_BAR
#undef PG8_SCHED
}
}

constexpr int NWAVES = 8;
constexpr int D = 2048, SEQ = 4096, NBP = 2, NBS = 8, LSMP = 4;
constexpr int MPROMPT = NBP * SEQ;
constexpr int MV = MPROMPT + NBS * LSMP;
constexpr int MP = 8448;
constexpr int FF = 5632, NUP = 2 * FF;
constexpr int AW = 1280, AH = 10, ADK = 128;
constexpr int BW = 768, NGRP = 3, HPG = 4, HD = 64;
constexpr int IN0 = 7444, IN0P = 7680, PLD = 7424;
constexpr int QB_OFF = 5120;
constexpr int IN1 = 6144;
constexpr int NSEQ = 10, NMOD = 9 * D;
constexpr int PASTLEN = 16384;
constexpr float EPS = 1e-6f;
constexpr float B_SCALE = 0.125f;
__host__ __device__ __forceinline__ int swaW(int g) { return 128 << (2 * g); }
__host__ __device__ __forceinline__ int swaD(int g) { return 1 << (2 * g); }

constexpr size_t O_YP = 0, O_YS = O_YP + (size_t)MPROMPT * D, O_PS = O_YS + (size_t)NBS * LSMP * D, O_PCONV = O_PS + (size_t)NBP * AH * 128 * 128,
    O_PKV0 = O_PCONV + (size_t)NBP * 3 * 3840, O_PKV1 = O_PKV0 + (size_t)NBP * 128 * 512, O_PKV2 = O_PKV1 + (size_t)NBP * 512 * 512, O_PSC = O_PKV2 + (size_t)NBP * 2048 * 512,
    O_SS = O_PSC + (size_t)NBP * 2 * D, O_SCONV = O_SS + (size_t)NBS * AH * 128 * 128, O_SKV0 = O_SCONV + (size_t)NBS * 3 * 3840, O_SKV1 = O_SKV0 + (size_t)NBS * 128 * 512,
    O_SKV2 = O_SKV1 + (size_t)NBS * 512 * 512, O_SSC = O_SKV2 + (size_t)NBS * 2048 * 512, O_END = O_SSC + (size_t)NBS * 2 * D;
static_assert(O_END == 32399872, "output size");

constexpr size_t MiB = 1u << 20;
constexpr size_t WS_CTL = 0, CTL_ZERO_BYTES = 1 * MiB;
constexpr size_t WS_MOD = 1 * MiB;
constexpr size_t WS_G = 3 * MiB;
constexpr size_t WS_BETA = 4 * MiB;
constexpr size_t WS_LSE = 5 * MiB;
constexpr size_t WS_AB = 6 * MiB;
constexpr size_t WS_WUP = 8 * MiB;
constexpr size_t WUP_STRIDE = (size_t)NUP * D * 2;
constexpr size_t WS_WDN = WS_WUP + 4 * WUP_STRIDE;
constexpr size_t WDN_STRIDE = (size_t)D * FF * 2;
constexpr size_t WS_WIN0 = WS_WDN + 4 * WDN_STRIDE;
constexpr size_t WS_WOUT0 = WS_WIN0 + (size_t)IN0P * D * 2;
constexpr size_t WS_WIN1 = WS_WOUT0 + (size_t)D * D * 2;
constexpr size_t WS_WOUT1 = WS_WIN1 + (size_t)IN1 * D * 2;
constexpr size_t WS_X = WS_WOUT1 + (size_t)D * D * 2;
constexpr size_t WS_H = WS_X + (size_t)MP * D * 4;
constexpr size_t WS_ACT = WS_H + (size_t)MP * D * 2;
constexpr size_t WS_PROJ = WS_ACT + (size_t)MP * FF * 2;
constexpr size_t WS_MIX = WS_PROJ + (size_t)MP * PLD * 2;
constexpr size_t WS_QKVC = WS_MIX + (size_t)MP * D * 2;
constexpr size_t WS_OA = WS_QKVC + (size_t)MP * 3840 * 2;
constexpr size_t WS_OB = WS_OA + (size_t)MP * AW * 4;
constexpr size_t WS_GT = WS_OB + (size_t)MP * BW * 4;
constexpr size_t WS_CHK = WS_GT + 8192;
constexpr size_t CHK_STRIDE = 90112, CHK_WN = 32768, CHK_QD = 49152, CHK_QK = 65536, CHK_KD = 73728;
constexpr int N_CHUNK_UNITS = NBP * AH * (SEQ / 64);
constexpr size_t WS_END = WS_CHK + (size_t)N_CHUNK_UNITS * CHK_STRIDE;
static_assert(WS_MOD + (size_t)2 * NSEQ * NMOD * 4 <= WS_G && WS_AB + (size_t)MP * 32 * 4 <= WS_WUP, "small buffers");
static_assert(WS_WUP % 256 == 0 && WS_X % 256 == 0 && WS_H % 256 == 0 && WS_ACT % 256 == 0 && WS_PROJ % 256 == 0 && WS_MIX % 256 == 0 && WS_QKVC % 256 == 0 && WS_OA % 256 == 0 && WS_OB % 256 == 0 && WS_CHK % 256 == 0, "alignment");

constexpr int CW_TMO = 0, CW_CODE = 1;
constexpr int CW_BAR = 4096;

constexpr int RING_OFF = 0, RING_BYTES = 131072;
constexpr int LDSCTL_OFF = RING_BYTES, MISC_OFF = LDSCTL_OFF + 320;
constexpr int LDS_BYTES = 147456;
constexpr int SM_OFF = RING_BYTES + 1024, SM_WAVE = 1536;
static_assert(MISC_OFF + 128 <= LDS_BYTES, "LDS map");

#define GAS __attribute__((address_space(1)))
#define LAS __attribute__((address_space(3)))
typedef unsigned short bf16;
typedef unsigned v4u __attribute__((ext_vector_type(4)));
typedef unsigned v2u __attribute__((ext_vector_type(2)));
typedef float f32x4 __attribute__((ext_vector_type(4)));
typedef float f32x2 __attribute__((ext_vector_type(2)));
typedef __bf16 bf16x2t __attribute__((ext_vector_type(2)));
typedef GAS unsigned gu32;
typedef float f32x16 __attribute__((ext_vector_type(16)));
typedef short bf16x8s __attribute__((ext_vector_type(8)));
#define RLX_AGENT __ATOMIC_RELAXED, __HIP_MEMORY_SCOPE_AGENT
#define LDS_WAIT() asm volatile("s_waitcnt lgkmcnt(0)" ::: "memory")
#define VM_WAIT() asm volatile("s_waitcnt vmcnt(0)" ::: "memory")
__device__ __forceinline__ unsigned f2bf(float f) { unsigned u = __builtin_bit_cast(unsigned, f); return (u + 0x7fffu + ((u >> 16) & 1u)) >> 16; }
__device__ __forceinline__ unsigned pk2(float lo, float hi) { const f32x2 v = {lo, hi}; return __builtin_bit_cast(unsigned, __builtin_convertvector(v, bf16x2t)); }
__device__ __forceinline__ float bf_lo(unsigned w) { return __builtin_bit_cast(float, w << 16); }
__device__ __forceinline__ float bf_hi(unsigned w) { return __builtin_bit_cast(float, w & 0xffff0000u); }
__device__ __forceinline__ float bf2f(bf16 h) { return __builtin_bit_cast(float, (unsigned)h << 16); }

#define XB_TMO      128
#define XB_XCNT(j)  (256  + 64 * (j))
#define XB_XSUB(j)  (1280 + 64 * (j))
#define XB_XGEN(j)  (2304 + 64 * (j))
#define XB_TOP      3328
#define XB_TOPGEN   3392
#define XCD_BAR_WORDS 3456
#define XB_SPIN_CAP (1u << 18)

__device__ __forceinline__ unsigned xb_ld(unsigned* p)              { return __hip_atomic_load(p, __ATOMIC_RELAXED, __HIP_MEMORY_SCOPE_AGENT); }
__device__ __forceinline__ unsigned xb_add(unsigned* p, unsigned v) { return __hip_atomic_fetch_add(p, v, __ATOMIC_RELAXED, __HIP_MEMORY_SCOPE_AGENT); }
__device__ __forceinline__ unsigned xb_xcc_id() { return (unsigned)__builtin_amdgcn_s_getreg((3 << 11) | 20) & 0xFu; }
#define XB_SPIN(cond, bar) do { unsigned _sp = 0; while (cond) { __builtin_amdgcn_s_sleep(1); \
    if ((++_sp & 255u) == 0u) { if (xb_ld(&(bar)[XB_TMO])) break; if (_sp > XB_SPIN_CAP) { atomicAdd(&(bar)[XB_TMO], 1u); break; } } } } while (0)

struct XcdBarrier {
    unsigned* bar; unsigned x;
    volatile LAS unsigned* st;
};
__device__ __forceinline__ XcdBarrier xcd_barrier_post(unsigned* bar, volatile LAS unsigned* st) {
    XcdBarrier b; b.bar = bar; b.x = xb_xcc_id(); b.st = st;
    if (threadIdx.x == 0) (void)xb_add(&bar[XB_XCNT(b.x)], 1u);
    return b;
}
__device__ __forceinline__ void xcd_barrier_complete(unsigned* bar, unsigned x, unsigned& nloc, unsigned& nx) {
    const unsigned G = gridDim.x * gridDim.y * gridDim.z;
    unsigned sum, cnt, mine, sp = 0u;
    for (;;) {
        sum = 0u; cnt = 0u; mine = 0u;
#pragma unroll
        for (unsigned j = 0; j < 16; ++j) { const unsigned c = xb_ld(&bar[XB_XCNT(j)]); sum += c; cnt += (c > 0u) ? 1u : 0u; mine = (j == x) ? c : mine; }
        if (sum == G) break;
        __builtin_amdgcn_s_sleep(1);
        if ((++sp & 255u) == 0u) { if (xb_ld(&bar[XB_TMO])) break; if (sp > XB_SPIN_CAP) { atomicAdd(&bar[XB_TMO], 1u); break; } }
    }
    nloc = mine > 0u ? mine : 1u; nx = cnt > 0u ? cnt : 1u;
}
__device__ __forceinline__ void xcd_barrier(const XcdBarrier& b) {
    asm volatile("s_waitcnt vmcnt(0)" ::: "memory");
    __syncthreads();
    if (threadIdx.x == 0) {
        unsigned* bar = b.bar;
        __builtin_amdgcn_s_waitcnt(0);
        unsigned nloc = b.st[0], nx = b.st[1];
        if (nloc == 0u) { xcd_barrier_complete(bar, b.x, nloc, nx); b.st[0] = nloc; b.st[1] = nx; }
        const unsigned old = xb_add(&bar[XB_XSUB(b.x)], 1u);
        const unsigned gen = old / nloc;
        if (old + 1u == (gen + 1u) * nloc) {
            __builtin_amdgcn_fence(__ATOMIC_RELEASE, "agent");
            asm volatile("s_waitcnt vmcnt(0)" ::: "memory");
            const unsigned og = xb_add(&bar[XB_TOP], 1u);
            const unsigned tg = og / nx;
            if (og + 1u == (tg + 1u) * nx) xb_add(&bar[XB_TOPGEN], 1u);
            else XB_SPIN(xb_ld(&bar[XB_TOPGEN]) == tg, bar);
            __builtin_amdgcn_fence(__ATOMIC_ACQUIRE, "agent");
            xb_add(&bar[XB_XGEN(b.x)], 1u);
            asm volatile("s_waitcnt vmcnt(0)" ::: "memory");
        } else {
            XB_SPIN(xb_ld(&bar[XB_XGEN(b.x)]) == gen, bar);
            __builtin_amdgcn_fence(__ATOMIC_ACQUIRE, "agent");
            asm volatile("s_waitcnt vmcnt(0)" ::: "memory");
        }
    }
    __syncthreads();
}

struct Args { const float* in[27]; float* out; unsigned char* ws; int ph_lo, ph_hi; };
struct Frame {
    LAS unsigned char* lds;
    volatile LAS unsigned* MISC;
    gu32* ctl;
    int tid, lane, wave;
    int vcu, G;
    float* out;
    unsigned char* ws;
};

__device__ __forceinline__ float wave_sum(float v) {
#pragma unroll
    for (int o = 1; o < 64; o <<= 1) v += __shfl_xor(v, o);
    return v;
}
__device__ __forceinline__ float wave_max(float v) {
#pragma unroll
    for (int o = 1; o < 64; o <<= 1) v = fmaxf(v, __shfl_xor(v, o));
    return v;
}

__device__ __forceinline__ int src_col(int kind, int rr) {
    if (kind == 0) return rr;
    if (kind == 1) { const int t = rr >> 8, cc = rr & 255; return cc < 128 ? t * 128 + cc : FF + t * 128 + (cc - 128); }
    if (kind == 2) { if (rr < 5120) return rr; if (rr < 7424) return rr + 20; if (rr < 7444) return rr - 7424 + 5120; return -1; }
    if (rr < 2048) return rr;
    { const int q = rr - 2048, t = q >> 8, cc = q & 255; return cc < 128 ? 2048 + t * 128 + cc : 4096 + t * 128 + (cc - 128); }
}
__device__ __forceinline__ void p0_conv_task(const float* W, int K, int N, bf16* WT, int kind, int task, int nblk, int lane) {
    const int kb = task / nblk, nb = task % nblk, rr0 = 256 * nb + 4 * lane;
    const int sc = src_col(kind, rr0);
    const float* src = W + (size_t)(64 * kb) * N + (sc >= 0 ? sc : 0);
    bf16* dst = WT + (size_t)rr0 * K + 64 * kb;
#pragma unroll 2
    for (int ks = 0; ks < 8; ++ks) {
        f32x4 v[8];
#pragma unroll
        for (int j = 0; j < 8; ++j) v[j] = sc >= 0 ? *(const f32x4*)(src + (size_t)(8 * ks + j) * N) : (f32x4){0.f, 0.f, 0.f, 0.f};
#pragma unroll
        for (int e = 0; e < 4; ++e) { v4u o; o.x = pk2(v[0][e], v[1][e]); o.y = pk2(v[2][e], v[3][e]); o.z = pk2(v[4][e], v[5][e]); o.w = pk2(v[6][e], v[7][e]);
            *(GAS v4u*)(dst + (size_t)e * K + 8 * ks) = o; }
    }
}
__device__ __forceinline__ void p0_weights(Frame& F, const Args& args) {
    const int gw = F.vcu * NWAVES + F.wave, NGW = F.G * NWAVES;
    constexpr int I_UP = (D / 64) * (NUP / 256), I_DN = (FF / 64) * (D / 256), I_IN0 = (D / 64) * (IN0P / 256), I_O = (D / 64) * (D / 256), I_IN1 = (D / 64) * (IN1 / 256);
    constexpr int NITEMS = 4 * I_UP + 4 * I_DN + I_IN0 + I_O + I_IN1 + I_O;
    for (int it = gw; it < NITEMS; it += NGW) {
        int r = it;
        if (r < 4 * I_UP) { const int w = r / I_UP; r -= w * I_UP;
            p0_conv_task((args.in[16]) + (size_t)w * D * NUP, D, NUP, (bf16*)(F.ws + WS_WUP + w * WUP_STRIDE), 1, r, NUP / 256, F.lane); continue; }
        r -= 4 * I_UP;
        if (r < 4 * I_DN) { const int w = r / I_DN; r -= w * I_DN;
            p0_conv_task((args.in[17]) + (size_t)w * FF * D, FF, D, (bf16*)(F.ws + WS_WDN + w * WDN_STRIDE), 0, r, D / 256, F.lane); continue; }
        r -= 4 * I_DN;
        if (r < I_IN0) { p0_conv_task((args.in[18]), D, IN0, (bf16*)(F.ws + WS_WIN0), 2, r, IN0P / 256, F.lane); continue; }
        r -= I_IN0;
        if (r < I_O) { p0_conv_task((args.in[23]), D, D, (bf16*)(F.ws + WS_WOUT0), 0, r, D / 256, F.lane); continue; }
        r -= I_O;
        if (r < I_IN1) { p0_conv_task((args.in[24]), D, IN1, (bf16*)(F.ws + WS_WIN1), 3, r, IN1 / 256, F.lane); continue; }
        r -= I_IN1;
        p0_conv_task((args.in[26]), D, D, (bf16*)(F.ws + WS_WOUT1), 0, r, D / 256, F.lane);
    }
}
__device__ __forceinline__ void p0_mod(Frame& F, const Args& args) {
    LAS float* SC = (LAS float*)(F.lds + RING_OFF);
    LAS float* RED = (LAS float*)(F.lds + RING_OFF + 81920);
    __syncthreads();
    for (int i = F.tid; i < NSEQ * D; i += NWAVES * 64) { const int s = i / D, k = i % D; const float c = s < NBP ? (args.in[2])[s * D + k] : (args.in[3])[(s - NBP) * D + k];
        SC[k * NSEQ + s] = c / (1.0f + __expf(-c)); }
    __syncthreads();
    for (int slab = F.vcu; slab < 256; slab += F.G) {
        const int l = slab >> 7, n0 = (slab & 127) * 144;
        float acc[NSEQ][4];
#pragma unroll
        for (int s = 0; s < NSEQ; ++s) { acc[s][0] = 0.f; acc[s][1] = 0.f; acc[s][2] = 0.f; acc[s][3] = 0.f; }
        if (F.lane < 36) {
            const float* wp = (args.in[10]) + ((size_t)l * D + F.wave * 256) * NMOD + n0 + 4 * F.lane;
            const LAS float* sp = SC + (F.wave * 256) * NSEQ;
#pragma unroll 8
            for (int k = 0; k < 256; ++k) { const f32x4 w = *(const f32x4*)(wp + (size_t)k * NMOD);
#pragma unroll
                for (int s = 0; s < NSEQ; ++s) { const float c = sp[k * NSEQ + s]; acc[s][0] += c * w[0]; acc[s][1] += c * w[1]; acc[s][2] += c * w[2]; acc[s][3] += c * w[3]; } }
#pragma unroll
            for (int s = 0; s < NSEQ; ++s)
#pragma unroll
                for (int j = 0; j < 4; ++j) RED[(F.wave * NSEQ + s) * 144 + 4 * F.lane + j] = acc[s][j];
        }
        __syncthreads();
        for (int i = F.tid; i < NSEQ * 144; i += NWAVES * 64) { const int s = i / 144, j = i % 144; float v = (args.in[11])[l * NMOD + n0 + j];
#pragma unroll
            for (int w = 0; w < 8; ++w) v += RED[(w * NSEQ + s) * 144 + j];
            ((float*)(F.ws + WS_MOD))[((size_t)l * NSEQ + s) * NMOD + n0 + j] = v; }
        __syncthreads();
    }
}

__device__ __forceinline__ void norm_phase(Frame& F, const Args& args, const float* gain, const float* shift, const float* scale, bool first) {
    const int gw = F.vcu * NWAVES + F.wave, NGW = F.G * NWAVES;
    for (int m = gw; m < MP; m += NGW) {
        GAS v4u* o16 = (GAS v4u*)(((bf16*)(F.ws + WS_H)) + (size_t)m * D);
        if (m >= MV) {
#pragma unroll
            for (int j = 0; j < 4; ++j) o16[64 * j + F.lane] = (v4u){0u, 0u, 0u, 0u};
            continue; }
        const float* src = first ? (m < MPROMPT ? (args.in[0]) + (size_t)m * D : (args.in[1]) + (size_t)(m - MPROMPT) * D) : ((float*)(F.ws + WS_X)) + (size_t)m * D;
        const int seq = pg8::seq_of_row(m);
        f32x4 v[4][2]; float ss = 0.f;
#pragma unroll
        for (int j = 0; j < 4; ++j)
#pragma unroll
            for (int h = 0; h < 2; ++h) { v[j][h] = *(const f32x4*)(src + 512 * j + 8 * F.lane + 4 * h); ss += (v[j][h].x * v[j][h].x + v[j][h].y * v[j][h].y) + (v[j][h].z * v[j][h].z + v[j][h].w * v[j][h].w); }
        if (first) {
#pragma unroll
            for (int j = 0; j < 4; ++j)
#pragma unroll
                for (int h = 0; h < 2; ++h) *(f32x4*)(((float*)(F.ws + WS_X)) + (size_t)m * D + 512 * j + 8 * F.lane + 4 * h) = v[j][h]; }
        const float rstd = 1.0f / sqrtf(wave_sum(ss) * (1.0f / D) + EPS);
        const float* shp = shift + (size_t)seq * NMOD; const float* scp = scale + (size_t)seq * NMOD;
#pragma unroll
        for (int j = 0; j < 4; ++j) { float r[8];
#pragma unroll
            for (int h = 0; h < 2; ++h) { const int e = 512 * j + 8 * F.lane + 4 * h; const f32x4 g = *(const f32x4*)(gain + e), sh = *(const f32x4*)(shp + e), sc = *(const f32x4*)(scp + e);
                const f32x4 y = (v[j][h] * rstd) * g * (sc + 1.0f) + sh; r[4 * h + 0] = y.x; r[4 * h + 1] = y.y; r[4 * h + 2] = y.z; r[4 * h + 3] = y.w; }
            v4u o; o.x = pk2(r[0], r[1]); o.y = pk2(r[2], r[3]); o.z = pk2(r[4], r[5]); o.w = pk2(r[6], r[7]);
            o16[64 * j + F.lane] = o; }
    }
}
__device__ __forceinline__ void final_norm_phase(Frame& F, const Args& args) {
    const int gw = F.vcu * NWAVES + F.wave, NGW = F.G * NWAVES;
    for (int m = gw; m < MV; m += NGW) {
        const float* src = ((float*)(F.ws + WS_X)) + (size_t)m * D; float* dst = F.out + O_YP + (size_t)m * D;
        f32x4 v[8]; float ss = 0.f;
#pragma unroll
        for (int j = 0; j < 8; ++j) { v[j] = *(const f32x4*)(src + 256 * j + 4 * F.lane); ss += (v[j].x * v[j].x + v[j].y * v[j].y) + (v[j].z * v[j].z + v[j].w * v[j].w); }
        const float rstd = 1.0f / sqrtf(wave_sum(ss) * (1.0f / D) + EPS);
#pragma unroll
        for (int j = 0; j < 8; ++j) { const f32x4 g = *(const f32x4*)((args.in[15]) + 256 * j + 4 * F.lane); *(f32x4*)(dst + 256 * j + 4 * F.lane) = (v[j] * rstd) * g; }
    }
}

__device__ __forceinline__ float softplus_f(float x) { return x > 20.f ? x : log1pf(__expf(x)); }
__device__ __forceinline__ void gdn_prep(Frame& F, const Args& args) {
    const int gw = F.vcu * NWAVES + F.wave, NGW = F.G * NWAVES;
    for (int id = gw; id < MV * AH; id += NGW) {
        const int m = id / AH, h = id % AH;
        const bool smp = m >= MPROMPT; const int t = smp ? ((m - MPROMPT) & 3) : (m & (SEQ - 1)); const int sb = smp ? ((m - MPROMPT) >> 2) : 0;
        float y[3][2];
#pragma unroll
        for (int part = 0; part < 3; ++part) {
            const int c = part * AW + h * ADK + 2 * F.lane;
            float a0 = 0.f, a1 = 0.f;
#pragma unroll
            for (int j = 0; j < 4; ++j) { const int tt = t - 3 + j; float x0, x1;
                if (tt >= 0) { const unsigned w = *(const unsigned*)(((bf16*)(F.ws + WS_PROJ)) + (size_t)(m - t + tt) * PLD + c); x0 = bf_lo(w); x1 = bf_hi(w); }
                else if (smp) { const f32x2 w = *(const f32x2*)((args.in[5]) + (size_t)(sb * 3 + (3 + tt)) * 3840 + c); x0 = w.x; x1 = w.y; }
                else { x0 = 0.f; x1 = 0.f; }
                const f32x2 cw = *(const f32x2*)((args.in[19]) + (size_t)j * 3840 + c); a0 += cw.x * x0; a1 += cw.y * x1; }
            y[part][0] = a0 / (1.0f + __expf(-a0)); y[part][1] = a1 / (1.0f + __expf(-a1));
        }
        const float sq = wave_sum(y[0][0] * y[0][0] + y[0][1] * y[0][1]), sk = wave_sum(y[1][0] * y[1][0] + y[1][1] * y[1][1]);
        const float rq = (1.0f / sqrtf(sq + EPS)) * 0.08838834764831845f, rk = 1.0f / sqrtf(sk + EPS);
        bf16* qrow = ((bf16*)(F.ws + WS_QKVC)) + (size_t)m * 3840 + h * ADK + 2 * F.lane;
        *(unsigned*)(qrow) = pk2(y[0][0] * rq, y[0][1] * rq); *(unsigned*)(qrow + AW) = pk2(y[1][0] * rk, y[1][1] * rk); *(unsigned*)(qrow + 2 * AW) = pk2(y[2][0], y[2][1]);
        if (F.lane == 0) { const float aa = ((float*)(F.ws + WS_AB))[(size_t)m * 32 + h], bb = ((float*)(F.ws + WS_AB))[(size_t)m * 32 + 10 + h];
            ((float*)(F.ws + WS_G))[(size_t)m * AH + h] = -__expf((args.in[20])[h]) * softplus_f(aa + (args.in[21])[h]); ((float*)(F.ws + WS_BETA))[(size_t)m * AH + h] = 1.0f / (1.0f + __expf(-bb)); }
    }
}
__device__ __forceinline__ unsigned cvtpk(float lo, float hi) { const f32x2 v = {lo, hi}; return __builtin_bit_cast(unsigned, __builtin_convertvector(v, bf16x2t)); }
__device__ __forceinline__ int pos4(int k4) { const int g = (k4 >> 2) & 3; return (k4 & ~15) + 4 * (((g & 1) << 1) | (g >> 1)); }
__device__ __forceinline__ bf16x8s pack8(const float (&x)[8]) { v4u w; w.x = cvtpk(x[0], x[1]); w.y = cvtpk(x[2], x[3]); w.z = cvtpk(x[4], x[5]); w.w = cvtpk(x[6], x[7]); return __builtin_bit_cast(bf16x8s, w); }
#define MFMA32(a, b, c) __builtin_amdgcn_mfma_f32_32x32x16_bf16((a), (b), (c), 0, 0, 0)

__device__ __forceinline__ void swa_prompt(Frame& F, const Args& args) {
    const int gw = F.vcu * NWAVES + F.wave, NGW = F.G * NWAVES;
    const bf16* PROJ = (const bf16*)(F.ws + WS_PROJ);
    float* OBp = (float*)(F.ws + WS_OB); float* LSEp = (float*)(F.ws + WS_LSE);
    for (int task = gw; task < 3072; task += NGW) {
        int l = F.lane; asm volatile("" : "+v"(l));
        const int r = l & 31, hh = l >> 5;
        const int b = task / 1536, r1 = task % 1536, g = r1 >> 9, r2 = r1 & 511, hs = r2 >> 7, rb = r2 & 127;
        const int d = swaD(g), nqb = 128 / d, res = rb / nqb, qb = rb % nqb, s0 = 32 * qb;
        const int hcol = (g * HPG + hs) * HD;
        const size_t rowb = (size_t)b * SEQ + res;
        bf16x8s idf[2];
#pragma unroll
        for (int s = 0; s < 2; ++s) { v4u w;
            w.x = (16 * s + 8 * hh + 0 == r ? 0x3F80u : 0u) | (16 * s + 8 * hh + 1 == r ? 0x3F800000u : 0u); w.y = (16 * s + 8 * hh + 2 == r ? 0x3F80u : 0u) | (16 * s + 8 * hh + 3 == r ? 0x3F800000u : 0u);
            w.z = (16 * s + 8 * hh + 4 == r ? 0x3F80u : 0u) | (16 * s + 8 * hh + 5 == r ? 0x3F800000u : 0u); w.w = (16 * s + 8 * hh + 6 == r ? 0x3F80u : 0u) | (16 * s + 8 * hh + 7 == r ? 0x3F800000u : 0u);
            idf[s] = __builtin_bit_cast(bf16x8s, w); }
        const bf16* qrow = PROJ + (rowb + (size_t)d * (s0 + r)) * PLD + QB_OFF + hcol + 8 * hh;
        bf16x8s qf[4];
#pragma unroll
        for (int s4 = 0; s4 < 4; ++s4) qf[s4] = *(const bf16x8s*)(qrow + 16 * s4);
        f32x16 T[5];
#pragma unroll
        for (int kt = 0; kt < 5; ++kt) {
            const int sk = s0 - 128 + 32 * kt + r; const int skc = sk < 0 ? 0 : sk;
            const bf16* krow = PROJ + (rowb + (size_t)d * skc) * PLD + QB_OFF + BW + hcol + 8 * hh;
#pragma unroll
            for (int i = 0; i < 16; ++i) T[kt][i] = 0.f;
#pragma unroll
            for (int s4 = 0; s4 < 4; ++s4) T[kt] = MFMA32(*(const bf16x8s*)(krow + 16 * s4), qf[s4], T[kt]);
        }
        float mx = -INFINITY;
#pragma unroll
        for (int kt = 0; kt < 5; ++kt)
#pragma unroll
            for (int i = 0; i < 16; ++i) { const int j = 32 * kt + (i & 3) + 8 * (i >> 2) + 4 * hh;
                const bool ok = (j >= r) && (j <= r + 128) && (s0 - 128 + j >= 0);
                const float v = ok ? T[kt][i] * B_SCALE : -INFINITY; T[kt][i] = v; mx = fmaxf(mx, v); }
        mx = fmaxf(mx, __shfl_xor(mx, 32));
        float sum = 0.f;
#pragma unroll
        for (int kt = 0; kt < 5; ++kt)
#pragma unroll
            for (int i = 0; i < 16; ++i) { const float p = __expf(T[kt][i] - mx); T[kt][i] = p; sum += p; }
        sum += __shfl_xor(sum, 32);
        const float rinv = 1.0f / sum;
        const size_t mq = rowb + (size_t)d * (s0 + r);
        if (hh == 0) LSEp[mq * 12 + g * HPG + hs] = mx + __logf(sum);
        f32x16 O[2];
#pragma unroll
        for (int dt = 0; dt < 2; ++dt)
#pragma unroll
            for (int i = 0; i < 16; ++i) O[dt][i] = 0.f;
#pragma unroll
        for (int kt = 0; kt < 5; ++kt) {
            const int sk = s0 - 128 + 32 * kt + r; const int skc = sk < 0 ? 0 : sk;
            const bf16* vrow = PROJ + (rowb + (size_t)d * skc) * PLD + QB_OFF + 2 * BW + hcol + 8 * hh;
            bf16x8s pa[2];
#pragma unroll
            for (int s2 = 0; s2 < 2; ++s2) { const float x[8] = {T[kt][8 * s2] * rinv, T[kt][8 * s2 + 1] * rinv, T[kt][8 * s2 + 2] * rinv, T[kt][8 * s2 + 3] * rinv, T[kt][8 * s2 + 4] * rinv, T[kt][8 * s2 + 5] * rinv, T[kt][8 * s2 + 6] * rinv, T[kt][8 * s2 + 7] * rinv}; pa[s2] = pack8(x); }
#pragma unroll
            for (int dt = 0; dt < 2; ++dt) {
                f32x16 XV;
#pragma unroll
                for (int i = 0; i < 16; ++i) XV[i] = 0.f;
#pragma unroll
                for (int s2 = 0; s2 < 2; ++s2) XV = MFMA32(*(const bf16x8s*)(vrow + 32 * dt + 16 * s2), idf[s2], XV);
#pragma unroll
                for (int s2 = 0; s2 < 2; ++s2) { const float x[8] = {XV[8 * s2], XV[8 * s2 + 1], XV[8 * s2 + 2], XV[8 * s2 + 3], XV[8 * s2 + 4], XV[8 * s2 + 5], XV[8 * s2 + 6], XV[8 * s2 + 7]};
                    O[dt] = MFMA32(pa[s2], pack8(x), O[dt]); }
            }
        }
#pragma unroll
        for (int dt = 0; dt < 2; ++dt)
#pragma unroll
            for (int i = 0; i < 16; ++i) { const int qi = (i & 3) + 8 * (i >> 2) + 4 * hh;
                OBp[(rowb + (size_t)d * (s0 + qi)) * BW + hcol + 32 * dt + r] = O[dt][i]; }
    }
}
__device__ __forceinline__ void swa_sample(Frame& F, const Args& args) {
    LAS float* Ps = (LAS float*)(F.lds + RING_OFF + 51200 + 16384) + F.wave * 132;
    const int gw = F.vcu * NWAVES + F.wave, NGW = F.G * NWAVES;
    for (int id = gw; id < NBS * LSMP * 12; id += NGW) {
        const int sb = id / 48, r1 = id % 48, t = r1 / 12, gh = r1 % 12, g = gh >> 2, hs = gh & 3;
        const int d = swaD(g), W = swaW(g);
        const float* cache = g == 0 ? (args.in[6]) : (g == 1 ? (args.in[7]) : (args.in[8]));
        const int hcol = gh * HD;
        const size_t mq = (size_t)(MPROMPT + sb * LSMP + t);
        const bf16* qrow = ((bf16*)(F.ws + WS_PROJ)) + mq * PLD + QB_OFF + hcol;
        float sc[3];
#pragma unroll
        for (int pass = 0; pass < 3; ++pass) {
            const int mm = pass * 64 + F.lane; float a = -INFINITY;
            if (mm <= 128) { const int p = t - d * mm; a = 0.f;
                if (p >= 0) { const bf16* kr = ((bf16*)(F.ws + WS_PROJ)) + (size_t)(MPROMPT + sb * LSMP + p) * PLD + QB_OFF + BW + hcol;
                    for (int e = 0; e < 64; e += 2) { const unsigned kw = *(const unsigned*)(kr + e), qw = *(const unsigned*)(qrow + e); a += bf_lo(qw) * bf_lo(kw) + bf_hi(qw) * bf_hi(kw); } }
                else { const float* kr = cache + ((size_t)(sb * W + (W + p)) * 2 + 0) * 256 + hs * HD;
                    for (int e = 0; e < 64; e += 2) { const f32x2 kw = *(const f32x2*)(kr + e); const unsigned qw = *(const unsigned*)(qrow + e); a += bf_lo(qw) * kw.x + bf_hi(qw) * kw.y; } }
                a *= B_SCALE; }
            sc[pass] = a;
        }
        const float mx = wave_max(fmaxf(fmaxf(sc[0], sc[1]), sc[2]));
        const float p0 = __expf(sc[0] - mx), p1 = __expf(sc[1] - mx), p2 = __expf(sc[2] - mx);
        const float den = wave_sum(p0 + p1 + p2), rden = 1.0f / den;
        Ps[F.lane] = p0 * rden; Ps[64 + F.lane] = p1 * rden; if (F.lane == 0) Ps[128] = p2 * rden;
        LDS_WAIT(); asm volatile("" ::: "memory");
        float o = 0.f;
        for (int mm = 0; mm <= 128; ++mm) { const int p = t - d * mm; float vv;
            if (p >= 0) vv = bf2f(((bf16*)(F.ws + WS_PROJ))[(size_t)(MPROMPT + sb * LSMP + p) * PLD + QB_OFF + 2 * BW + hcol + F.lane]);
            else vv = cache[((size_t)(sb * W + (W + p)) * 2 + 1) * 256 + hs * HD + F.lane];
            o += Ps[mm] * vv; }
        ((float*)(F.ws + WS_OB))[mq * BW + hcol + F.lane] = o;
        if (F.lane == 0) ((float*)(F.ws + WS_LSE))[mq * 12 + gh] = mx + __logf(den);
        LDS_WAIT(); asm volatile("" ::: "memory");
    }
}
__device__ __forceinline__ void mixer0_copies(Frame& F, const Args& args) {
    const long gt = (long)F.vcu * (NWAVES * 64) + F.tid, NGT = (long)F.G * NWAVES * 64;
    for (long i = gt; i < (long)(NBP + NBS) * 3 * 3840; i += NGT) { const int c = (int)(i % 3840), j = (int)((i / 3840) % 3), s = (int)(i / (3 * 3840));
        if (s < NBP) F.out[O_PCONV + (size_t)(s * 3 + j) * 3840 + c] = bf2f(((bf16*)(F.ws + WS_PROJ))[(size_t)(s * SEQ + SEQ - 3 + j) * PLD + c]);
        else { const int sb = s - NBP; F.out[O_SCONV + (size_t)(sb * 3 + j) * 3840 + c] = bf2f(((bf16*)(F.ws + WS_PROJ))[(size_t)(MPROMPT + sb * LSMP + 1 + j) * PLD + c]); } }
#pragma unroll
    for (int g = 0; g < 3; ++g) {
        const int W = g == 0 ? 128 : (g == 1 ? 512 : 2048);
        const size_t op = g == 0 ? O_PKV0 : (g == 1 ? O_PKV1 : O_PKV2), os = g == 0 ? O_SKV0 : (g == 1 ? O_SKV1 : O_SKV2);
        const float* cache = g == 0 ? (args.in[6]) : (g == 1 ? (args.in[7]) : (args.in[8]));
        const long np = (long)NBP * W * 128, ns = (long)NBS * W * 128;
        for (long i = gt; i < np + ns; i += NGT) {
            const bool smp = i >= np; const long q = smp ? i - np : i;
            const int e4 = (int)(q & 15), hs = (int)((q >> 4) & 3), kv = (int)((q >> 6) & 1), j = (int)((q >> 7) % W), s = (int)((q >> 7) / W);
            const int pcol = QB_OFF + (kv + 1) * BW + (g * HPG + hs) * HD + 4 * e4;
            f32x4 v;
            if (!smp) { const v2u w = *(const v2u*)(((bf16*)(F.ws + WS_PROJ)) + (size_t)(s * SEQ + SEQ - W + j) * PLD + pcol); v = (f32x4){bf_lo(w.x), bf_hi(w.x), bf_lo(w.y), bf_hi(w.y)};
                *(f32x4*)(F.out + op + (size_t)q * 4) = v; }
            else { if (j < W - LSMP) v = *(const f32x4*)(cache + (((size_t)(s * W + j + LSMP) * 2 + kv) * 4 + hs) * 64 + 4 * e4);
                else { const v2u w = *(const v2u*)(((bf16*)(F.ws + WS_PROJ)) + (size_t)(MPROMPT + s * LSMP + (j - (W - LSMP))) * PLD + pcol); v = (f32x4){bf_lo(w.x), bf_hi(w.x), bf_lo(w.y), bf_hi(w.y)}; }
                *(f32x4*)(F.out + os + (size_t)q * 4) = v; }
        }
    }
}
__device__ __forceinline__ void gdn_scan_naive(Frame& F, const Args& args) {
    LAS bf16* Kb = (LAS bf16*)(F.lds + RING_OFF);
    LAS bf16* Qb = (LAS bf16*)(F.lds + RING_OFF + 16384);
    LAS bf16* Vb = (LAS bf16*)(F.lds + RING_OFF + 32768);
    LAS float* gb = (LAS float*)(F.lds + RING_OFF + 40960);
    LAS float* bb = gb + 64;
    for (int task = 2 * NBP * AH + (F.G - 1 - F.vcu); task < 200; task += F.G) {
        const int chain = task >> 1, hf = task & 1;
        const bool smp = chain >= NBP * AH;
        const int seq = smp ? NBP + (chain - NBP * AH) / AH : chain / AH, h = smp ? (chain - NBP * AH) % AH : chain % AH;
        const int L = smp ? LSMP : SEQ, m0 = smp ? MPROMPT + (seq - NBP) * LSMP : seq * SEQ;
        const int vc = F.lane & 7, kg = F.lane >> 3, v0 = hf * 64 + F.wave * 8;
        float s[16];
        if (smp) {
#pragma unroll
            for (int i = 0; i < 16; ++i) s[i] = (args.in[4])[(((size_t)(seq - NBP) * AH + h) * 128 + kg * 16 + i) * 128 + v0 + vc];
        } else {
#pragma unroll
            for (int i = 0; i < 16; ++i) s[i] = 0.f;
        }
        for (int t0 = 0; t0 < L; t0 += 64) {
            const int nb = (L - t0) < 64 ? (L - t0) : 64;
            __syncthreads();
            for (int i = F.tid; i < nb * 16; i += NWAVES * 64) { const int tt = i >> 4, ch = i & 15; const bf16* rowp = ((bf16*)(F.ws + WS_QKVC)) + (size_t)(m0 + t0 + tt) * 3840 + h * ADK + 8 * ch;
                *(LAS v4u*)(Qb + tt * 128 + 8 * ch) = *(const v4u*)rowp; *(LAS v4u*)(Kb + tt * 128 + 8 * ch) = *(const v4u*)(rowp + AW);
                if (ch < 8) *(LAS v4u*)(Vb + tt * 64 + 8 * ch) = *(const v4u*)(rowp + 2 * AW + hf * 64); }
            if (F.tid < nb) { gb[F.tid] = __expf(((float*)(F.ws + WS_G))[(size_t)(m0 + t0 + F.tid) * AH + h]); bb[F.tid] = ((float*)(F.ws + WS_BETA))[(size_t)(m0 + t0 + F.tid) * AH + h]; }
            __syncthreads();
            for (int tt = 0; tt < nb; ++tt) {
                const float a = gb[tt], be = bb[tt];
                const v4u k0 = *(const LAS v4u*)(Kb + tt * 128 + kg * 16), k1 = *(const LAS v4u*)(Kb + tt * 128 + kg * 16 + 8);
                const v4u q0 = *(const LAS v4u*)(Qb + tt * 128 + kg * 16), q1 = *(const LAS v4u*)(Qb + tt * 128 + kg * 16 + 8);
                const float vv = bf2f(Vb[tt * 64 + F.wave * 8 + vc]);
                float kf[16], qf[16];
                kf[0] = bf_lo(k0.x); kf[1] = bf_hi(k0.x); kf[2] = bf_lo(k0.y); kf[3] = bf_hi(k0.y); kf[4] = bf_lo(k0.z); kf[5] = bf_hi(k0.z); kf[6] = bf_lo(k0.w); kf[7] = bf_hi(k0.w);
                kf[8] = bf_lo(k1.x); kf[9] = bf_hi(k1.x); kf[10] = bf_lo(k1.y); kf[11] = bf_hi(k1.y); kf[12] = bf_lo(k1.z); kf[13] = bf_hi(k1.z); kf[14] = bf_lo(k1.w); kf[15] = bf_hi(k1.w);
                qf[0] = bf_lo(q0.x); qf[1] = bf_hi(q0.x); qf[2] = bf_lo(q0.y); qf[3] = bf_hi(q0.y); qf[4] = bf_lo(q0.z); qf[5] = bf_hi(q0.z); qf[6] = bf_lo(q0.w); qf[7] = bf_hi(q0.w);
                qf[8] = bf_lo(q1.x); qf[9] = bf_hi(q1.x); qf[10] = bf_lo(q1.y); qf[11] = bf_hi(q1.y); qf[12] = bf_lo(q1.z); qf[13] = bf_hi(q1.z); qf[14] = bf_lo(q1.w); qf[15] = bf_hi(q1.w);
                float part = 0.f;
#pragma unroll
                for (int i = 0; i < 16; ++i) { s[i] *= a; part += kf[i] * s[i]; }
                part += __shfl_xor(part, 8); part += __shfl_xor(part, 16); part += __shfl_xor(part, 32);
                const float dl = be * (vv - part);
                float op = 0.f;
#pragma unroll
                for (int i = 0; i < 16; ++i) { s[i] += kf[i] * dl; op += qf[i] * s[i]; }
                op += __shfl_xor(op, 8); op += __shfl_xor(op, 16); op += __shfl_xor(op, 32);
                if (kg == 0) ((float*)(F.ws + WS_OA))[(size_t)(m0 + t0 + tt) * AW + h * ADK + v0 + vc] = op;
            }
        }
        float* so = F.out + (smp ? O_SS + ((size_t)(seq - NBP) * AH + h) * 16384 : O_PS + ((size_t)seq * AH + h) * 16384);
#pragma unroll
        for (int i = 0; i < 16; ++i) so[(size_t)(kg * 16 + i) * 128 + v0 + vc] = s[i];
    }
    __syncthreads();
}

__device__ __forceinline__ void gdn_chunk_prep(Frame& F, const Args& args) {
    const int gw = F.vcu * NWAVES + F.wave, NGW = F.G * NWAVES;
    LAS float* ALDS = (LAS float*)(F.lds + RING_OFF + F.wave * 16384);
    LAS bf16* TL = (LAS bf16*)ALDS;
    LAS float* GAM = (LAS float*)(F.lds + SM_OFF + F.wave * SM_WAVE);
    LAS float* BET = GAM + 64;
    LAS float* EG = GAM + 128;
    LAS float* EGB = GAM + 192;
    LAS float* KDS = GAM + 256;
    const bf16* QKVC = (const bf16*)(F.ws + WS_QKVC);
    for (int u = gw; u < N_CHUNK_UNITS; u += NGW) {
        int l = F.lane; asm volatile("" : "+v"(l));
        const int r = l & 31, hh = l >> 5;
        const int chain = u >> 6, n = u & 63, b = chain / AH, h = chain % AH, mbase = b * SEQ + 64 * n;
        unsigned char* cb = F.ws + WS_CHK + (size_t)u * CHK_STRIDE;
        {
            const float gl = ((const float*)(F.ws + WS_G))[(size_t)(mbase + l) * AH + h], bl = ((const float*)(F.ws + WS_BETA))[(size_t)(mbase + l) * AH + h];
            float gam = gl;
#pragma unroll
            for (int off = 1; off < 64; off <<= 1) { const float t = __shfl_up(gam, off); if (l >= off) gam += t; }
            const float glast = __shfl(gam, 63);
            const float eg = __expf(gam);
            GAM[l] = gam; BET[l] = bl; EG[l] = eg; EGB[l] = bl * eg; KDS[l] = __expf(glast - gam);
            if (l == 63) ((float*)(F.ws + WS_GT))[u] = eg;
        }
        LDS_WAIT(); asm volatile("" ::: "memory");
        const bf16* qp = QKVC + (size_t)(mbase + r) * 3840 + h * ADK + 8 * hh;
        {
            f32x16 KK00, KK10, KK11;
#pragma unroll
            for (int i = 0; i < 16; ++i) { KK00[i] = 0.f; KK10[i] = 0.f; KK11[i] = 0.f; }
#pragma unroll 4
            for (int s = 0; s < 8; ++s) {
                const bf16x8s kf0 = *(const bf16x8s*)(qp + AW + 16 * s), kf1 = *(const bf16x8s*)(qp + AW + 32 * 3840 + 16 * s);
                KK00 = MFMA32(kf0, kf0, KK00); KK10 = MFMA32(kf1, kf0, KK10); KK11 = MFMA32(kf1, kf1, KK11);
            }
#define GDN_A_TILE(acc, mt, nt) do { const int col = 32 * (nt) + r; const float gamc = GAM[col]; \
            _Pragma("unroll") for (int i4 = 0; i4 < 4; ++i4) { const int rb = 32 * (mt) + 8 * i4 + 4 * hh; const f32x4 gr = *(const LAS f32x4*)(GAM + rb), br = *(const LAS f32x4*)(BET + rb); \
                _Pragma("unroll") for (int e = 0; e < 4; ++e) { const int row = rb + e; ALDS[row * 64 + col] = row > col ? br[e] * acc[4 * i4 + e] * __expf(gr[e] - gamc) : 0.f; } } } while (0)
            GDN_A_TILE(KK00, 0, 0); GDN_A_TILE(KK10, 1, 0); GDN_A_TILE(KK11, 1, 1);
#undef GDN_A_TILE
        }
        asm volatile("" ::: "memory");
        {
            f32x16 KQ00, KQ01, KQ11;
#pragma unroll
            for (int i = 0; i < 16; ++i) { KQ00[i] = 0.f; KQ01[i] = 0.f; KQ11[i] = 0.f; }
#pragma unroll 4
            for (int s = 0; s < 8; ++s) {
                const bf16x8s kf0 = *(const bf16x8s*)(qp + AW + 16 * s), kf1 = *(const bf16x8s*)(qp + AW + 32 * 3840 + 16 * s);
                const bf16x8s qf0 = *(const bf16x8s*)(qp + 16 * s), qf1 = *(const bf16x8s*)(qp + 32 * 3840 + 16 * s);
                KQ00 = MFMA32(kf0, qf0, KQ00); KQ01 = MFMA32(kf0, qf1, KQ01); KQ11 = MFMA32(kf1, qf1, KQ11);
            }
            bf16* QK = (bf16*)(cb + CHK_QK);
#define GDN_QK_TILE(acc, jt, it, zero) do { const int i_ = 32 * (it) + r; const float gami = GAM[i_]; \
            _Pragma("unroll") for (int i4 = 0; i4 < 4; ++i4) { const int j4 = 32 * (jt) + 8 * i4 + 4 * hh; const f32x4 gj = *(const LAS f32x4*)(GAM + j4); float x[4]; \
                _Pragma("unroll") for (int e = 0; e < 4; ++e) x[e] = (!(zero) && i_ >= j4 + e) ? acc[4 * i4 + e] * __expf(gami - gj[e]) : 0.f; \
                v2u w; w.x = cvtpk(x[0], x[1]); w.y = cvtpk(x[2], x[3]); *(v2u*)(QK + (size_t)i_ * 64 + pos4(j4)) = w; } } while (0)
            GDN_QK_TILE(KQ00, 0, 0, false); GDN_QK_TILE(KQ01, 0, 1, false); GDN_QK_TILE(KQ11, 1, 1, false); GDN_QK_TILE(KQ00, 1, 0, true);
#undef GDN_QK_TILE
        }
        LDS_WAIT(); asm volatile("" ::: "memory");
        float t[64];
#pragma unroll
        for (int i = 0; i < 64; ++i) {
            float s0 = 0.f;
#pragma unroll
            for (int jq = 0; jq < (i + 3) / 4; ++jq) { const f32x4 a = *(const LAS f32x4*)(ALDS + i * 64 + 4 * jq);
#pragma unroll
                for (int e = 0; e < 4; ++e) if (4 * jq + e < i) s0 = __builtin_fmaf(a[e], t[4 * jq + e], s0); }
            t[i] = (l == i ? 1.f : 0.f) - s0;
        }
        asm volatile("" ::: "memory");
        {
            const int pc = pos4(l & ~3) + (l & 3);
#pragma unroll
            for (int i = 0; i < 64; i += 2) { const unsigned w = cvtpk(t[i], t[i + 1]); TL[i * 72 + pc] = (bf16)(w & 0xffffu); TL[(i + 1) * 72 + pc] = (bf16)(w >> 16); }
        }
        LDS_WAIT(); asm volatile("" ::: "memory");
#define GDN_TFRAG(mt, S4) (*(const LAS bf16x8s*)(TL + (32 * (mt) + r) * 72 + 16 * (S4) + 8 * hh))
        bf16x8s idf[2];
#pragma unroll
        for (int s = 0; s < 2; ++s) { v4u w;
            w.x = (16 * s + 8 * hh + 0 == r ? 0x3F80u : 0u) | (16 * s + 8 * hh + 1 == r ? 0x3F800000u : 0u); w.y = (16 * s + 8 * hh + 2 == r ? 0x3F80u : 0u) | (16 * s + 8 * hh + 3 == r ? 0x3F800000u : 0u);
            w.z = (16 * s + 8 * hh + 4 == r ? 0x3F80u : 0u) | (16 * s + 8 * hh + 5 == r ? 0x3F800000u : 0u); w.w = (16 * s + 8 * hh + 6 == r ? 0x3F80u : 0u) | (16 * s + 8 * hh + 7 == r ? 0x3F800000u : 0u);
            idf[s] = __builtin_bit_cast(bf16x8s, w); }
#pragma unroll 1
        for (int vs = 0; vs < 4; ++vs) {
            bf16x8s bfr[2][2];
#pragma unroll
            for (int tt = 0; tt < 2; ++tt) {
                f32x16 X;
#pragma unroll
                for (int i = 0; i < 16; ++i) X[i] = 0.f;
#pragma unroll
                for (int s = 0; s < 2; ++s) X = MFMA32(*(const bf16x8s*)(qp + 2 * AW + (size_t)tt * 32 * 3840 + 32 * vs + 16 * s), idf[s], X);
#pragma unroll
                for (int s = 0; s < 2; ++s) { const f32x4 b0 = *(const LAS f32x4*)(BET + 32 * tt + 16 * s + 4 * hh), b1 = *(const LAS f32x4*)(BET + 32 * tt + 16 * s + 8 + 4 * hh);
                    const float x[8] = {X[8 * s + 0] * b0[0], X[8 * s + 1] * b0[1], X[8 * s + 2] * b0[2], X[8 * s + 3] * b0[3], X[8 * s + 4] * b1[0], X[8 * s + 5] * b1[1], X[8 * s + 6] * b1[2], X[8 * s + 7] * b1[3]};
                    bfr[tt][s] = pack8(x); }
            }
#pragma unroll
            for (int mt = 0; mt < 2; ++mt) {
                f32x16 U;
#pragma unroll
                for (int i = 0; i < 16; ++i) U[i] = 0.f;
#pragma unroll
                for (int S4 = 0; S4 < 4; ++S4) U = MFMA32(GDN_TFRAG(mt, S4), bfr[S4 >> 1][S4 & 1], U);
#pragma unroll
                for (int q = 0; q < 4; ++q) *(f32x4*)(cb + ((size_t)((vs * 2 + mt) * 4 + q) * 64 + l) * 16) = (f32x4){U[4 * q], U[4 * q + 1], U[4 * q + 2], U[4 * q + 3]};
            }
        }
#pragma unroll 1
        for (int kt = 0; kt < 4; ++kt) {
            bf16x8s afr[2][2];
            bf16* KD = (bf16*)(cb + CHK_KD); bf16* WN = (bf16*)(cb + CHK_WN);
#pragma unroll
            for (int tt = 0; tt < 2; ++tt) {
                f32x16 X;
#pragma unroll
                for (int i = 0; i < 16; ++i) X[i] = 0.f;
#pragma unroll
                for (int s = 0; s < 2; ++s) X = MFMA32(*(const bf16x8s*)(qp + AW + (size_t)tt * 32 * 3840 + 32 * kt + 16 * s), idf[s], X);
#pragma unroll
                for (int i4 = 0; i4 < 4; ++i4) { const int j4 = 32 * tt + 8 * i4 + 4 * hh; const f32x4 kd = *(const LAS f32x4*)(KDS + j4);
                    v2u w; w.x = cvtpk(X[4 * i4] * kd[0], X[4 * i4 + 1] * kd[1]); w.y = cvtpk(X[4 * i4 + 2] * kd[2], X[4 * i4 + 3] * kd[3]);
                    *(v2u*)(KD + (size_t)(32 * kt + r) * 64 + pos4(j4)) = w; }
#pragma unroll
                for (int s = 0; s < 2; ++s) { const f32x4 b0 = *(const LAS f32x4*)(EGB + 32 * tt + 16 * s + 4 * hh), b1 = *(const LAS f32x4*)(EGB + 32 * tt + 16 * s + 8 + 4 * hh);
                    const float x[8] = {X[8 * s + 0] * b0[0], X[8 * s + 1] * b0[1], X[8 * s + 2] * b0[2], X[8 * s + 3] * b0[3], X[8 * s + 4] * b1[0], X[8 * s + 5] * b1[1], X[8 * s + 6] * b1[2], X[8 * s + 7] * b1[3]};
                    afr[tt][s] = pack8(x); }
            }
#pragma unroll
            for (int it = 0; it < 2; ++it) {
                f32x16 WT;
#pragma unroll
                for (int i = 0; i < 16; ++i) WT[i] = 0.f;
#pragma unroll
                for (int S4 = 0; S4 < 4; ++S4) WT = MFMA32(afr[S4 >> 1][S4 & 1], GDN_TFRAG(it, S4), WT);
#pragma unroll
                for (int i4 = 0; i4 < 4; ++i4) { const int k4 = 32 * kt + 8 * i4 + 4 * hh;
                    v2u w; w.x = cvtpk(-WT[4 * i4], -WT[4 * i4 + 1]); w.y = cvtpk(-WT[4 * i4 + 2], -WT[4 * i4 + 3]);
                    *(v2u*)(WN + (size_t)(32 * it + r) * 128 + pos4(k4)) = w; }
            }
        }
#undef GDN_TFRAG
        {
            bf16* QD = (bf16*)(cb + CHK_QD); const int chn = l & 15;
#pragma unroll 4
            for (int itr = 0; itr < 16; ++itr) { const int i = 4 * itr + (l >> 4); const float eg = EG[i];
                const v4u qv = *(const v4u*)(QKVC + (size_t)(mbase + i) * 3840 + h * ADK + 8 * chn);
                v2u lo, hi; lo.x = cvtpk(bf_lo(qv.x) * eg, bf_hi(qv.x) * eg); lo.y = cvtpk(bf_lo(qv.y) * eg, bf_hi(qv.y) * eg); hi.x = cvtpk(bf_lo(qv.z) * eg, bf_hi(qv.z) * eg); hi.y = cvtpk(bf_lo(qv.w) * eg, bf_hi(qv.w) * eg);
                bf16* dst = QD + (size_t)i * 128 + 16 * (chn >> 1) + ((chn & 1) ? 4 : 0);
                *(v2u*)dst = lo; *(v2u*)(dst + 8) = hi; }
        }
        LDS_WAIT(); asm volatile("" ::: "memory");
    }
}

__device__ __forceinline__ void gdn_chunk_scan(Frame& F, const Args& args) {
    if (F.wave != 0) return;
    const int l = F.lane, r = l & 31, hh = l >> 5;
    for (int task = F.vcu; task < NBP * AH * 4; task += F.G) {
        const int chain = task >> 2, vs = task & 3, b = chain / AH, h = chain % AH;
        const unsigned char* cb0 = F.ws + WS_CHK + (size_t)chain * 64 * CHK_STRIDE;
        const float gtv = ((const float*)(F.ws + WS_GT))[chain * 64 + l];
        const unsigned offU = (unsigned)((vs * 8) * 64 + l) * 16u;
        const unsigned offW = (unsigned)CHK_WN + (unsigned)(r * 128 + 8 * hh) * 2u;
        const unsigned offQ = (unsigned)CHK_QD + (unsigned)(r * 128 + 8 * hh) * 2u;
        const unsigned offK = (unsigned)CHK_QK + (unsigned)(r * 64 + 8 * hh) * 2u;
        const unsigned offD = (unsigned)CHK_KD + (unsigned)(r * 64 + 8 * hh) * 2u;
#define GDN_DMA(src, slot, bufb) __builtin_amdgcn_global_load_lds((const unsigned*)(src), (LAS unsigned*)(F.lds + RING_OFF + (bufb) * 65536 + (slot) * 1024), 16, 0, 0)
#define GDN_ISSUE(n_, bufb) do { const unsigned char* cbn = cb0 + (size_t)(n_) * CHK_STRIDE; \
            _Pragma("unroll 1") for (int sl = 0; sl < 8; ++sl) GDN_DMA(cbn + offU + sl * 1024, sl, bufb); \
            _Pragma("unroll 1") for (int j = 0; j < 16; ++j) { GDN_DMA(cbn + offW + (j >> 3) * 8192 + (j & 7) * 32, 8 + j, bufb); GDN_DMA(cbn + offQ + (j >> 3) * 8192 + (j & 7) * 32, 24 + j, bufb); } \
            _Pragma("unroll 1") for (int j = 0; j < 8; ++j) GDN_DMA(cbn + offK + (j >> 2) * 4096 + (j & 3) * 32, 40 + j, bufb); \
            _Pragma("unroll 1") for (int j = 0; j < 16; ++j) GDN_DMA(cbn + offD + (j >> 2) * 4096 + (j & 3) * 32, 48 + j, bufb); } while (0)
        f32x16 Sacc[4];
#pragma unroll
        for (int kt = 0; kt < 4; ++kt)
#pragma unroll
            for (int i = 0; i < 16; ++i) Sacc[kt][i] = 0.f;
        GDN_ISSUE(0, 0);
        float* OA = (float*)(F.ws + WS_OA) + (size_t)(b * SEQ) * AW + h * ADK + 32 * vs + r;
#pragma unroll 1
        for (int n = 0; n < 64; ++n) {
            asm volatile("s_waitcnt vmcnt(0)" ::: "memory");
            if (n + 1 < 64) { const int nb_ = (n + 1) & 1; GDN_ISSUE(n + 1, nb_); }
            __builtin_amdgcn_sched_barrier(0);
            const float gt = __builtin_bit_cast(float, __builtin_amdgcn_readlane(__builtin_bit_cast(int, gtv), n));
            const LAS unsigned char* B = F.lds + RING_OFF + (n & 1) * 65536 + l * 16;
#define GDN_SLOT(sl) (*(const LAS bf16x8s*)(B + (sl) * 1024))
            bf16x8s Sb[4][2];
#pragma unroll
            for (int kt = 0; kt < 4; ++kt)
#pragma unroll
                for (int s = 0; s < 2; ++s) { const float x[8] = {Sacc[kt][8 * s], Sacc[kt][8 * s + 1], Sacc[kt][8 * s + 2], Sacc[kt][8 * s + 3], Sacc[kt][8 * s + 4], Sacc[kt][8 * s + 5], Sacc[kt][8 * s + 6], Sacc[kt][8 * s + 7]}; Sb[kt][s] = pack8(x); }
            f32x16 Up[2];
#pragma unroll
            for (int mt = 0; mt < 2; ++mt)
#pragma unroll
                for (int q = 0; q < 4; ++q) { const f32x4 uq = *(const LAS f32x4*)(B + (mt * 4 + q) * 1024); Up[mt][4 * q] = uq[0]; Up[mt][4 * q + 1] = uq[1]; Up[mt][4 * q + 2] = uq[2]; Up[mt][4 * q + 3] = uq[3]; }
#pragma unroll
            for (int S8 = 0; S8 < 8; ++S8)
#pragma unroll
                for (int mt = 0; mt < 2; ++mt) Up[mt] = MFMA32(GDN_SLOT(8 + mt * 8 + S8), Sb[S8 >> 1][S8 & 1], Up[mt]);
            bf16x8s Ub[2][2];
#pragma unroll
            for (int mt = 0; mt < 2; ++mt)
#pragma unroll
                for (int s = 0; s < 2; ++s) { const float x[8] = {Up[mt][8 * s], Up[mt][8 * s + 1], Up[mt][8 * s + 2], Up[mt][8 * s + 3], Up[mt][8 * s + 4], Up[mt][8 * s + 5], Up[mt][8 * s + 6], Up[mt][8 * s + 7]}; Ub[mt][s] = pack8(x); }
            {
                f32x16 O[2];
#pragma unroll
                for (int mt = 0; mt < 2; ++mt)
#pragma unroll
                    for (int i = 0; i < 16; ++i) O[mt][i] = 0.f;
#pragma unroll
                for (int S8 = 0; S8 < 8; ++S8)
#pragma unroll
                    for (int mt = 0; mt < 2; ++mt) O[mt] = MFMA32(GDN_SLOT(24 + mt * 8 + S8), Sb[S8 >> 1][S8 & 1], O[mt]);
#pragma unroll
                for (int S4 = 0; S4 < 4; ++S4)
#pragma unroll
                    for (int mt = 0; mt < 2; ++mt) if (S4 < 2 * (mt + 1)) O[mt] = MFMA32(GDN_SLOT(40 + mt * 4 + S4), Ub[S4 >> 1][S4 & 1], O[mt]);
#pragma unroll
                for (int mt = 0; mt < 2; ++mt)
#pragma unroll
                    for (int i = 0; i < 16; ++i) OA[(size_t)(64 * n + 32 * mt + (i & 3) + 8 * (i >> 2) + 4 * hh) * AW] = O[mt][i];
            }
#pragma unroll
            for (int kt = 0; kt < 4; ++kt)
#pragma unroll
                for (int i = 0; i < 16; ++i) Sacc[kt][i] *= gt;
#pragma unroll
            for (int S4 = 0; S4 < 4; ++S4)
#pragma unroll
                for (int kt = 0; kt < 4; ++kt) Sacc[kt] = MFMA32(GDN_SLOT(48 + kt * 4 + S4), Ub[S4 >> 1][S4 & 1], Sacc[kt]);
#undef GDN_SLOT
        }
        float* so = F.out + O_PS + (size_t)chain * 16384 + 32 * vs + r;
#pragma unroll
        for (int kt = 0; kt < 4; ++kt)
#pragma unroll
            for (int i = 0; i < 16; ++i) so[(size_t)(32 * kt + (i & 3) + 8 * (i >> 2) + 4 * hh) * 128] = Sacc[kt][i];
        asm volatile("s_waitcnt vmcnt(0)" ::: "memory");
#undef GDN_DMA
#undef GDN_ISSUE
    }
}

__device__ __forceinline__ void mixer0_gate(Frame& F, const Args& args) {
    const int gw = F.vcu * NWAVES + F.wave, NGW = F.G * NWAVES;
    const f32x2 on = *(const f32x2*)((args.in[22]) + 2 * F.lane);
    for (int m = gw; m < MV; m += NGW) {
        bf16* mrow = ((bf16*)(F.ws + WS_MIX)) + (size_t)m * D;
#pragma unroll 2
        for (int h = 0; h < AH; ++h) { const f32x2 o = *(const f32x2*)(((float*)(F.ws + WS_OA)) + (size_t)m * AW + h * ADK + 2 * F.lane);
            const float rs = 1.0f / sqrtf(wave_sum(o.x * o.x + o.y * o.y) * (1.0f / 128.0f) + EPS);
            const unsigned zw = *(const unsigned*)(((bf16*)(F.ws + WS_PROJ)) + (size_t)m * PLD + 3840 + h * ADK + 2 * F.lane); const float z0 = bf_lo(zw), z1 = bf_hi(zw);
            *(unsigned*)(mrow + h * ADK + 2 * F.lane) = pk2(o.x * rs * on.x * (z0 / (1.0f + __expf(-z0))), o.y * rs * on.y * (z1 / (1.0f + __expf(-z1)))); }
#pragma unroll
        for (int hs = 0; hs < HPG; ++hs) { const float l0 = ((float*)(F.ws + WS_LSE))[(size_t)m * 12 + hs], l1 = ((float*)(F.ws + WS_LSE))[(size_t)m * 12 + 4 + hs], l2 = ((float*)(F.ws + WS_LSE))[(size_t)m * 12 + 8 + hs];
            const float mx = fmaxf(fmaxf(l0, l1), l2), e0 = __expf(l0 - mx), e1 = __expf(l1 - mx), e2 = __expf(l2 - mx), rs = 1.0f / (e0 + e1 + e2);
            const float al[3] = {e0 * rs, e1 * rs, e2 * rs};
#pragma unroll
            for (int g = 0; g < 3; ++g) { const int col = (g * HPG + hs) * HD + F.lane; mrow[AW + col] = (bf16)f2bf(((float*)(F.ws + WS_OB))[(size_t)m * BW + col] * al[g]); } }
    }
}
__device__ __forceinline__ void mixer1_conv(Frame& F, const Args& args) {
    const bf16* BG = ((bf16*)(F.ws + WS_PROJ)); const bf16* P = ((bf16*)(F.ws + WS_PROJ)) + (size_t)MP * D;
    const long gt = (long)F.vcu * (NWAVES * 64) + F.tid, NGT = (long)F.G * NWAVES * 64;
    for (long i = gt; i < (long)MV * 256; i += NGT) {
        const int m = (int)(i >> 8), c = (int)(i & 255) * 8;
        const bool smp = m >= MPROMPT; const int t = smp ? ((m - MPROMPT) & 3) : (m & (SEQ - 1)); const int sb = smp ? ((m - MPROMPT) >> 2) : 0;
        float y[8];
#pragma unroll
        for (int e = 0; e < 8; ++e) y[e] = 0.f;
#pragma unroll
        for (int j = 0; j < 3; ++j) { const int tt = t - 2 + j; float pv[8];
            if (tt >= 0) { const v4u w = *(const v4u*)(P + (size_t)(m - t + tt) * D + c); pv[0] = bf_lo(w.x); pv[1] = bf_hi(w.x); pv[2] = bf_lo(w.y); pv[3] = bf_hi(w.y); pv[4] = bf_lo(w.z); pv[5] = bf_hi(w.z); pv[6] = bf_lo(w.w); pv[7] = bf_hi(w.w); }
            else if (smp) { const float* sp = (args.in[9]) + (size_t)(sb * 2 + (2 + tt)) * D + c; const f32x4 a = *(const f32x4*)sp, b = *(const f32x4*)(sp + 4);
                pv[0] = a.x; pv[1] = a.y; pv[2] = a.z; pv[3] = a.w; pv[4] = b.x; pv[5] = b.y; pv[6] = b.z; pv[7] = b.w; }
            else {
#pragma unroll
                for (int e = 0; e < 8; ++e) pv[e] = 0.f; }
            const f32x4 w0 = *(const f32x4*)((args.in[25]) + (size_t)j * D + c), w1 = *(const f32x4*)((args.in[25]) + (size_t)j * D + c + 4);
            y[0] += w0.x * pv[0]; y[1] += w0.y * pv[1]; y[2] += w0.z * pv[2]; y[3] += w0.w * pv[3]; y[4] += w1.x * pv[4]; y[5] += w1.y * pv[5]; y[6] += w1.z * pv[6]; y[7] += w1.w * pv[7]; }
        const v4u bw = *(const v4u*)(BG + (size_t)m * D + c);
        v4u o; o.x = pk2(bf_lo(bw.x) * y[0], bf_hi(bw.x) * y[1]); o.y = pk2(bf_lo(bw.y) * y[2], bf_hi(bw.y) * y[3]); o.z = pk2(bf_lo(bw.z) * y[4], bf_hi(bw.z) * y[5]); o.w = pk2(bf_lo(bw.w) * y[6], bf_hi(bw.w) * y[7]);
        *(v4u*)(((bf16*)(F.ws + WS_MIX)) + (size_t)m * D + c) = o;
    }
    for (long i = gt; i < (long)(NBP + NBS) * 2 * D; i += NGT) { const int c = (int)(i % D), j = (int)((i / D) % 2), s = (int)(i / (2 * D));
        if (s < NBP) F.out[O_PSC + (size_t)(s * 2 + j) * D + c] = bf2f(P[(size_t)(s * SEQ + SEQ - 2 + j) * D + c]);
        else { const int sb = s - NBP; F.out[O_SSC + (size_t)(sb * 2 + j) * D + c] = bf2f(P[(size_t)(MPROMPT + sb * LSMP + 2 + j) * D + c]); } }
}


template <int MODE, int KSPLIT, int NSB>
__device__ __forceinline__ void skinny_phase(Frame& F, const bf16* Abase, const bf16* Bt, const int K, const int ntasks, const float* gate, const float scale) {
    static_assert(KSPLIT == 1 || MODE == 1, "only the residual epilogue accumulates");
    LAS float* T = (LAS float*)(F.lds + RING_OFF);
    const int r = F.lane & 31, h = F.lane >> 5, kw = K / (8 * KSPLIT), ns = kw >> 4;
    unsigned char* ws = F.ws;
    for (int tk_ = F.G - 1 - (int)blockIdx.x; tk_ < ntasks * KSPLIT; tk_ += F.G) {
        const int tsk = tk_ / KSPLIT, kq = tk_ % KSPLIT;
        int row0, row1;
        if (MODE == 0) { row0 = 256 * (tsk >> 2) + 32 * (tsk & 3); row1 = row0 + 128; }
        else if (MODE == 3 && tsk >= 32) { const int j = tsk - 32; row0 = 256 * (8 + (j >> 2)) + 32 * (j & 3); row1 = row0 + 128; }
        else { row0 = 64 * tsk; row1 = row0 + 32; }
        const int kbeg = (kq * 8 + F.wave) * kw + 8 * h;
        const bf16* w0 = Bt + (size_t)(row0 + r) * K + kbeg;
        const bf16* w1 = Bt + (size_t)(row1 + r) * K + kbeg;
        const bf16* tk = Abase + (size_t)(MPROMPT + r) * K + kbeg;
        f32x16 acc0, acc1;
#pragma unroll
        for (int i = 0; i < 16; ++i) { acc0[i] = 0.f; acc1[i] = 0.f; }
#pragma unroll 1
        for (int s0 = 0; s0 < ns; s0 += NSB) {
            bf16x8s a0[NSB], a1[NSB], bb[NSB];
#pragma unroll
            for (int s = 0; s < NSB; ++s) { a0[s] = *(const bf16x8s*)(w0 + 16 * (s0 + s)); a1[s] = *(const bf16x8s*)(w1 + 16 * (s0 + s)); bb[s] = *(const bf16x8s*)(tk + 16 * (s0 + s)); }
#pragma unroll
            for (int s = 0; s < NSB; ++s) { acc0 = __builtin_amdgcn_mfma_f32_32x32x16_bf16(a0[s], bb[s], acc0, 0, 0, 0); acc1 = __builtin_amdgcn_mfma_f32_32x32x16_bf16(a1[s], bb[s], acc1, 0, 0, 0); }
        }
        __syncthreads();
#pragma unroll
        for (int i = 0; i < 16; ++i) { const int n = (i & 3) + 8 * (i >> 2) + 4 * h;
            T[((F.wave * 2 + 0) * 32 + n) * 32 + r] = acc0[i]; T[((F.wave * 2 + 1) * 32 + n) * 32 + r] = acc1[i]; }
        __syncthreads();
        const int tok = F.tid & 31, n0 = 2 * (F.tid >> 5), row = MPROMPT + tok;
        float v[2][2];
#pragma unroll
        for (int t = 0; t < 2; ++t)
#pragma unroll
            for (int e = 0; e < 2; ++e) { float a = 0.f;
#pragma unroll
                for (int w = 0; w < 8; ++w) a += T[((w * 2 + t) * 32 + n0 + e) * 32 + tok];
                v[t][e] = a; }
        if (MODE == 0) { const int ocol = (row0 >> 8) * 128 + (row0 & 127) + n0;
            *(unsigned*)((bf16*)(ws + WS_ACT) + (size_t)row * FF + ocol) = pk2(pg8::silu_f(v[0][0]) * v[1][0], pg8::silu_f(v[0][1]) * v[1][1]); }
        else if (MODE == 1) { const int seq = pg8::seq_of_row(row);
#pragma unroll
            for (int t = 0; t < 2; ++t) { const int col = (t ? row1 : row0) + n0; float* xp = (float*)(ws + WS_X) + (size_t)row * D + col; const float* gp = gate + (size_t)seq * NMOD + col;
                const f32x2 gv = *(const f32x2*)gp;
                if (KSPLIT == 1) { f32x2 xv = *(f32x2*)xp; xv.x += scale * gv.x * v[t][0]; xv.y += scale * gv.y * v[t][1]; *(f32x2*)xp = xv; }
                else { __hip_atomic_fetch_add(xp, scale * gv.x * v[t][0], __ATOMIC_RELAXED, __HIP_MEMORY_SCOPE_AGENT); __hip_atomic_fetch_add(xp + 1, scale * gv.y * v[t][1], __ATOMIC_RELAXED, __HIP_MEMORY_SCOPE_AGENT); } } }
        else if (MODE == 2) {
            if (row0 < PLD) {
#pragma unroll
                for (int t = 0; t < 2; ++t) *(unsigned*)((bf16*)(ws + WS_PROJ) + (size_t)row * PLD + (t ? row1 : row0) + n0) = pk2(v[t][0], v[t][1]); }
            else { *(f32x2*)((float*)(ws + WS_AB) + (size_t)row * 32 + n0) = (f32x2){v[0][0], v[0][1]}; } }
        else {
            if (row0 < D) {
#pragma unroll
                for (int t = 0; t < 2; ++t) *(unsigned*)((bf16*)(ws + WS_PROJ) + (size_t)row * D + (t ? row1 : row0) + n0) = pk2(v[t][0], v[t][1]); }
            else { const int pcol = ((row0 >> 8) - 8) * 128 + (row0 & 127) + n0;
                *(unsigned*)((bf16*)(ws + WS_PROJ) + (size_t)MP * D + (size_t)row * D + pcol) = pk2(v[0][0] * v[1][0], v[0][1] * v[1][1]); } }
    }
    __syncthreads();
}

#define IN_PH() (lo <= pid && pid < hi)
#define SEAM() do { if (MK_N_LAUNCHES == 1 && lo <= pid && pid + 1 < hi) xcd_barrier(bar); ++pid; } while (0)
template <int L, int SUB>
__device__ __forceinline__ void sublayer(Frame& F, const Args& args, const XcdBarrier& bar, int& pid, const int lo, const int hi) {
    unsigned char* ws = F.ws;
    const float* modl = (const float*)(ws + WS_MOD) + (size_t)L * NSEQ * NMOD;
    if (IN_PH()) { const float* gain = args.in[SUB == 0 ? 12 : (SUB == 1 ? 13 : 14)] + (size_t)L * D;
        norm_phase(F, args, gain, modl + (size_t)(3 * SUB) * D, modl + (size_t)(3 * SUB + 1) * D, L == 0 && SUB == 0); }
    SEAM();
    if constexpr (SUB != 1) {
        constexpr int f = SUB >> 1;
        if (IN_PH()) { pg8::Gemm g{(const pg8::bf16_t*)(ws + WS_H), (const pg8::bf16_t*)(ws + WS_WUP + (size_t)(L * 2 + f) * WUP_STRIDE), MPROMPT, NUP, D}; pg8::StaticOrder S; S.init(MPROMPT, NUP, F.G, (int)blockIdx.x);
            pg8::EpiSwiglu E{(pg8::bf16_t*)(ws + WS_ACT), FF};
            pg8::gemm_phase<pg8::EpiSwiglu, pg8::StaticOrder, true, true>(F.lds + RING_OFF, g, S, E);
            skinny_phase<0, 1, 8>(F, (const bf16*)(ws + WS_H), (const bf16*)(ws + WS_WUP + (size_t)(L * 2 + f) * WUP_STRIDE), D, 176, nullptr, 0.f); }
        SEAM();
        if (IN_PH()) { pg8::Gemm g{(const pg8::bf16_t*)(ws + WS_ACT), (const pg8::bf16_t*)(ws + WS_WDN + (size_t)(L * 2 + f) * WDN_STRIDE), MPROMPT, D, FF}; pg8::StaticOrder S; S.init(MPROMPT, D, F.G, (int)blockIdx.x);
            pg8::EpiResid E{(float*)(ws + WS_X), modl + (size_t)(3 * SUB + 2) * D, 0.5f};
            pg8::gemm_phase<pg8::EpiResid, pg8::StaticOrder, true, true>(F.lds + RING_OFF, g, S, E);
            skinny_phase<1, 1, 11>(F, (const bf16*)(ws + WS_ACT), (const bf16*)(ws + WS_WDN + (size_t)(L * 2 + f) * WDN_STRIDE), FF, 32, modl + (size_t)(3 * SUB + 2) * D, 0.5f); }
        SEAM();
    } else {
        if constexpr (L == 0) {
            if (IN_PH()) { pg8::Gemm g{(const pg8::bf16_t*)(ws + WS_H), (const pg8::bf16_t*)(ws + WS_WIN0), MPROMPT, IN0P, D}; pg8::StaticOrder S; S.init(MPROMPT, IN0P, F.G, (int)blockIdx.x);
                pg8::EpiIn0 E{(pg8::bf16_t*)(ws + WS_PROJ), PLD, (float*)(ws + WS_AB)};
                pg8::gemm_phase<pg8::EpiIn0, pg8::StaticOrder, true, true>(F.lds + RING_OFF, g, S, E);
                skinny_phase<2, 1, 8>(F, (const bf16*)(ws + WS_H), (const bf16*)(ws + WS_WIN0), D, 117, nullptr, 0.f); }
            SEAM();
            if (IN_PH()) { gdn_prep(F, args); swa_prompt(F, args); swa_sample(F, args); mixer0_copies(F, args); }
            SEAM();
            if (IN_PH()) { gdn_chunk_prep(F, args); }
            SEAM();
            if (IN_PH()) { gdn_chunk_scan(F, args); __syncthreads(); gdn_scan_naive(F, args); }
            SEAM();
            if (IN_PH()) { mixer0_gate(F, args); }
            SEAM();
        } else {
            if (IN_PH()) { pg8::Gemm g{(const pg8::bf16_t*)(ws + WS_H), (const pg8::bf16_t*)(ws + WS_WIN1), MPROMPT, IN1, D}; pg8::StaticOrder S; S.init(MPROMPT, IN1, F.G, (int)blockIdx.x);
                pg8::EpiIn1 E{(pg8::bf16_t*)(ws + WS_PROJ), (pg8::bf16_t*)(ws + WS_PROJ) + (size_t)MP * D};
                pg8::gemm_phase<pg8::EpiIn1, pg8::StaticOrder, true, true>(F.lds + RING_OFF, g, S, E);
                skinny_phase<3, 1, 8>(F, (const bf16*)(ws + WS_H), (const bf16*)(ws + WS_WIN1), D, 96, nullptr, 0.f); }
            SEAM();
            if (IN_PH()) { mixer1_conv(F, args); }
            SEAM();
        }
        if (IN_PH()) { pg8::Gemm g{(const pg8::bf16_t*)(ws + WS_MIX), (const pg8::bf16_t*)(ws + (L == 0 ? WS_WOUT0 : WS_WOUT1)), MPROMPT, D, D}; pg8::StaticOrder S; S.init(MPROMPT, D, F.G, (int)blockIdx.x);
            pg8::EpiResid E{(float*)(ws + WS_X), modl + (size_t)(3 * SUB + 2) * D, 1.0f};
            pg8::gemm_phase<pg8::EpiResid, pg8::StaticOrder, true, true>(F.lds + RING_OFF, g, S, E);
            skinny_phase<1, 1, 8>(F, (const bf16*)(ws + WS_MIX), (const bf16*)(ws + (L == 0 ? WS_WOUT0 : WS_WOUT1)), D, 32, modl + (size_t)(3 * SUB + 2) * D, 1.0f); }
        SEAM();
    }
}

__global__ void __launch_bounds__(NWAVES * 64, 2) fwd(Args args) {
    extern __shared__ __attribute__((aligned(16))) unsigned char lds[];
    Frame F;
    F.lds = (LAS unsigned char*)lds;
    F.MISC = (volatile LAS unsigned*)(F.lds + MISC_OFF);
    F.tid = threadIdx.x; F.lane = F.tid & 63; F.wave = __builtin_amdgcn_readfirstlane(F.tid >> 6);
    F.G = gridDim.x; { const int bx = blockIdx.x; F.vcu = (F.G % 8 == 0) ? (bx % 8) * (F.G / 8) + bx / 8 : bx; }
    F.ws = args.ws; F.out = args.out;
    F.ctl = (gu32*)(args.ws + WS_CTL);
    for (int u = F.tid; u < (LDS_BYTES - LDSCTL_OFF) / 4; u += NWAVES * 64) ((LAS unsigned*)(F.lds + LDSCTL_OFF))[u] = 0u;
    __syncthreads();
    XcdBarrier bar; bar.bar = (unsigned*)(F.ctl + CW_BAR); bar.x = 0; bar.st = nullptr;
    if (MK_N_LAUNCHES == 1) bar = xcd_barrier_post((unsigned*)(F.ctl + CW_BAR), F.MISC + 8);

    const int lo = args.ph_lo, hi = args.ph_hi;
    int pid = 0;
    if (IN_PH()) { p0_weights(F, args); p0_mod(F, args); }
    SEAM();
    sublayer<0, 0>(F, args, bar, pid, lo, hi);
    sublayer<0, 1>(F, args, bar, pid, lo, hi);
    sublayer<0, 2>(F, args, bar, pid, lo, hi);
    sublayer<1, 0>(F, args, bar, pid, lo, hi);
    sublayer<1, 1>(F, args, bar, pid, lo, hi);
    sublayer<1, 2>(F, args, bar, pid, lo, hi);
    if (IN_PH()) { final_norm_phase(F, args); }
}
#undef IN_PH
#undef SEAM
constexpr int N_PHASES = 1 + (3 + 3 + 4 + 3) + (3 + 3 + 3 + 1) + 1;

extern "C" void kernel_launch(void* const* d_in, const int* in_sizes, int n_in, void* d_out, int out_size, void* d_ws, size_t ws_size, hipStream_t stream) {
    static int grid = 0;
    if (grid == 0) {
        if (n_in != 27 || out_size != (int)O_END || ws_size < WS_END) { fprintf(stderr, "kernel_launch: expected 27 inputs, %zu outputs, >= %zu B workspace; got %d, %d, %zu\n", (size_t)O_END, (size_t)WS_END, n_in, out_size, ws_size); grid = -1; return; }
        int dev = 0, cus = 0, per_cu = 0;
        if (hipGetDevice(&dev) != hipSuccess || hipDeviceGetAttribute(&cus, hipDeviceAttributeMultiprocessorCount, dev) != hipSuccess) { fprintf(stderr, "kernel_launch: device query failed\n"); grid = -1; return; }
        if (hipFuncSetAttribute((const void*)fwd, hipFuncAttributeMaxDynamicSharedMemorySize, LDS_BYTES) != hipSuccess) { fprintf(stderr, "kernel_launch: hipFuncSetAttribute failed\n"); grid = -1; return; }
        if (hipOccupancyMaxActiveBlocksPerMultiprocessor(&per_cu, (const void*)fwd, NWAVES * 64, LDS_BYTES) != hipSuccess || per_cu < 1)
            fprintf(stderr, "kernel_launch: note: occupancy query reports %d workgroups per CU\n", per_cu);
        (void)hipGetLastError();
        grid = cus;
    }
    if (grid < 0) return;
    if (hipMemsetAsync((char*)d_ws + WS_CTL, 0, CTL_ZERO_BYTES, stream) != hipSuccess) { fprintf(stderr, "kernel_launch: memset failed\n"); return; }
    Args a{};
    for (int i = 0; i < 27; ++i) a.in[i] = (const float*)d_in[i];
    a.out = (float*)d_out; a.ws = (unsigned char*)d_ws;
    if (MK_N_LAUNCHES == 1) {
        a.ph_lo = 0; a.ph_hi = N_PHASES;
        hipLaunchKernelGGL(fwd, dim3(grid), dim3(NWAVES * 64), LDS_BYTES, stream, a);
    } else {
        for (int p = 0; p < N_PHASES; ++p) { a.ph_lo = p; a.ph_hi = p + 1; hipLaunchKernelGGL(fwd, dim3(grid), dim3(NWAVES * 64), LDS_BYTES, stream, a); }
    }
    const hipError_t le = hipPeekAtLastError();
    if (le != hipSuccess) fprintf(stderr, "kernel_launch: launch failed: %s\n", hipGetErrorName(le));
}
```

```cpp
#include <hip/hip_runtime.h>
#include <cstdio>
#include <cstdint>

#ifndef MK_N_LAUNCHES
#define MK_N_LAUNCHES 1
#endif

namespace pg8 {
#define PG8_LAS __attribute__((address_space(3)))
typedef unsigned short bf16_t;
typedef short bf16x8 __attribute__((ext_vector_type(8)));
typedef float f32x4 __attribute__((ext_vector_type(4)));
typedef unsigned u32x4 __attribute__((ext_vector_type(4)));
constexpr int BM = 256, BK = 64, HALF = 128, HTB = HALF * BK * 2, STAGE_BYTES = 8 * HTB, NXCD = 8, WGM = 8;

__host__ __device__ __forceinline__ int lds_byte(int r, int c) { const int st = (r >> 4) * 2 + (c >> 5), rr = r & 15, cc = c & 31, ob = rr * 64 + cc * 2; return st * 1024 + (ob ^ (((ob >> 9) & 1) << 5)); }
__host__ __device__ __forceinline__ void stage_rc(int b, int& R, int& C) { const int st = b / 1024, sb = b % 1024, swz = sb ^ (((sb >> 9) & 1) << 5); R = (st >> 1) * 16 + swz / 64; C = (st & 1) * 32 + (swz % 64) / 2; }
__host__ __device__ __forceinline__ int perm32(int rho) { const int n = rho >> 4, i = rho & 15; return 8 * (i >> 2) + 4 * n + (i & 3); }

struct Unit { int pm, pn; };
struct Gemm { const bf16_t* A; const bf16_t* Bt; int M, N, K; };

struct StaticOrder {
    int nM, nN, nwg, G, c;
    __host__ __device__ void init(int M, int N, int G_, int c_) { nM = M / BM; nN = N / BM; nwg = nM * nN; G = G_; c = c_; }
    __host__ __device__ bool next(int i, Unit& u) const {
        const long L = (long)i * G + c; if (L >= nwg) return false;
        int wgid = (int)L; { const int q = nwg / NXCD, r = nwg % NXCD, xcd = wgid % NXCD, off = wgid / NXCD; wgid = (xcd < r ? xcd * (q + 1) : r * (q + 1) + (xcd - r) * q) + off; }
        const int nig = WGM * nN, gid = wgid / nig, fm = gid * WGM, gsz = (nM - fm) < WGM ? (nM - fm) : WGM;
        u.pm = fm + ((wgid % nig) % gsz); u.pn = (wgid % nig) / gsz; return true;
    }
    __device__ __forceinline__ void a_ready(const Unit&) const {}
    __device__ __forceinline__ void done(const Unit&) const {}
};

__device__ __forceinline__ unsigned cvt_pk_bf16(float lo, float hi) { unsigned r; asm volatile("v_cvt_pk_bf16_f32 %0, %1, %2" : "=v"(r) : "v"(lo), "v"(hi)); return r; }
__device__ __forceinline__ float silu_f(float x) { return x * __builtin_amdgcn_rcpf(1.0f + __expf(-x)); }

constexpr int E_MV = 8224, E_MPROMPT = 8192, E_D = 2048, E_NMOD = 18432;
__device__ __forceinline__ int seq_of_row(int r) { return r < E_MPROMPT ? (r >> 12) : 2 + ((r - E_MPROMPT) >> 2); }

struct EpiSwiglu {
    static constexpr bool PERM = true, AFTER_DRAIN = false;
    bf16_t* O; int ldc;
    __device__ __forceinline__ void operator()(const f32x4 (&acc)[2][2][4][2], const Unit& u, int wr, int wc, int fr, int fq) const {
        const int row0 = u.pm * BM + wr * 64 + fr, col0 = u.pn * HALF + wc * 32 + 8 * fq;
#pragma unroll
        for (int ai = 0; ai < 2; ++ai)
#pragma unroll
            for (int m = 0; m < 4; ++m) { bf16_t* rowp = O + (size_t)(row0 + ai * HALF + m * 16) * ldc + col0;
                const f32x4 g0 = acc[ai][0][m][0], g1 = acc[ai][0][m][1], u0 = acc[ai][1][m][0], u1 = acc[ai][1][m][1];
                u32x4 w; w.x = cvt_pk_bf16(silu_f(g0[0]) * u0[0], silu_f(g0[1]) * u0[1]); w.y = cvt_pk_bf16(silu_f(g0[2]) * u0[2], silu_f(g0[3]) * u0[3]);
                w.z = cvt_pk_bf16(silu_f(g1[0]) * u1[0], silu_f(g1[1]) * u1[1]); w.w = cvt_pk_bf16(silu_f(g1[2]) * u1[2], silu_f(g1[3]) * u1[3]);
                *(u32x4*)rowp = w; }
    }
};
struct EpiResid {
    static constexpr bool PERM = false, AFTER_DRAIN = false;
    float* X; const float* gate; float scale;
    __device__ __forceinline__ void operator()(const f32x4 (&acc)[2][2][4][2], const Unit& u, int wr, int wc, int fr, int fq) const {
        const int col0 = u.pn * BM + wc * 32 + 4 * fq;
#pragma unroll
        for (int ai = 0; ai < 2; ++ai)
#pragma unroll
            for (int m = 0; m < 4; ++m) { const int r = u.pm * BM + ai * HALF + wr * 64 + m * 16 + fr;
                if (r < E_MV) { const float* gp = gate + (size_t)seq_of_row(r) * E_NMOD + col0; float* xp = X + (size_t)r * E_D + col0;
#pragma unroll
                    for (int bj = 0; bj < 2; ++bj)
#pragma unroll
                        for (int n = 0; n < 2; ++n) { const f32x4 gv = *(const f32x4*)(gp + bj * HALF + n * 16); f32x4 xv = *(const f32x4*)(xp + bj * HALF + n * 16);
                            xv = xv + (gv * scale) * acc[ai][bj][m][n]; *(f32x4*)(xp + bj * HALF + n * 16) = xv; } }
                if (m & 1) asm volatile("" ::: "memory"); }
    }
};
struct EpiIn0 {
    static constexpr bool PERM = true, AFTER_DRAIN = false;
    bf16_t* O; int ldc; float* AB;
    __device__ __forceinline__ void operator()(const f32x4 (&acc)[2][2][4][2], const Unit& u, int wr, int wc, int fr, int fq) const {
        const int row0 = u.pm * BM + wr * 64 + fr;
        if (u.pn < 29) { const int col0 = u.pn * BM + wc * 32 + 8 * fq;
#pragma unroll
            for (int ai = 0; ai < 2; ++ai)
#pragma unroll
                for (int m = 0; m < 4; ++m) { bf16_t* rowp = O + (size_t)(row0 + ai * HALF + m * 16) * ldc + col0;
#pragma unroll
                    for (int bj = 0; bj < 2; ++bj) { const f32x4 v0 = acc[ai][bj][m][0], v1 = acc[ai][bj][m][1];
                        u32x4 w; w.x = cvt_pk_bf16(v0[0], v0[1]); w.y = cvt_pk_bf16(v0[2], v0[3]); w.z = cvt_pk_bf16(v1[0], v1[1]); w.w = cvt_pk_bf16(v1[2], v1[3]);
                        *(u32x4*)(rowp + bj * HALF) = w; } }
        } else if (wc == 0) {
#pragma unroll
            for (int ai = 0; ai < 2; ++ai)
#pragma unroll
                for (int m = 0; m < 4; ++m) { float* rowp = AB + (size_t)(row0 + ai * HALF + m * 16) * 32 + 8 * fq;
                    *(f32x4*)rowp = acc[ai][0][m][0]; *(f32x4*)(rowp + 4) = acc[ai][0][m][1]; }
        }
    }
};
struct EpiIn1 {
    static constexpr bool PERM = true, AFTER_DRAIN = false;
    bf16_t* BG; bf16_t* P;
    __device__ __forceinline__ void operator()(const f32x4 (&acc)[2][2][4][2], const Unit& u, int wr, int wc, int fr, int fq) const {
        const int row0 = u.pm * BM + wr * 64 + fr;
        if (u.pn < 8) { const int col0 = u.pn * BM + wc * 32 + 8 * fq;
#pragma unroll
            for (int ai = 0; ai < 2; ++ai)
#pragma unroll
                for (int m = 0; m < 4; ++m) { bf16_t* rowp = BG + (size_t)(row0 + ai * HALF + m * 16) * E_D + col0;
#pragma unroll
                    for (int bj = 0; bj < 2; ++bj) { const f32x4 v0 = acc[ai][bj][m][0], v1 = acc[ai][bj][m][1];
                        u32x4 w; w.x = cvt_pk_bf16(v0[0], v0[1]); w.y = cvt_pk_bf16(v0[2], v0[3]); w.z = cvt_pk_bf16(v1[0], v1[1]); w.w = cvt_pk_bf16(v1[2], v1[3]);
                        *(u32x4*)(rowp + bj * HALF) = w; } }
        } else { const int col0 = (u.pn - 8) * HALF + wc * 32 + 8 * fq;
#pragma unroll
            for (int ai = 0; ai < 2; ++ai)
#pragma unroll
                for (int m = 0; m < 4; ++m) { bf16_t* rowp = P + (size_t)(row0 + ai * HALF + m * 16) * E_D + col0;
                    const f32x4 a0 = acc[ai][0][m][0], a1 = acc[ai][0][m][1], b0 = acc[ai][1][m][0], b1 = acc[ai][1][m][1];
                    u32x4 w; w.x = cvt_pk_bf16(a0[0] * b0[0], a0[1] * b0[1]); w.y = cvt_pk_bf16(a0[2] * b0[2], a0[3] * b0[3]);
                    w.z = cvt_pk_bf16(a1[0] * b1[0], a1[1] * b1[1]); w.w = cvt_pk_bf16(a1[2] * b1[2], a1[3] * b1[3]);
                    *(u32x4*)rowp = w; }
        }
    }
};

template <class Epi, class Sched, bool ALIGN_EPI = false, bool SP2 = false>
__device__ __forceinline__ void gemm_phase(PG8_LAS unsigned char* lds, const Gemm g, const Sched& S, const Epi& E) {
    const int tid = threadIdx.x, wid = __builtin_amdgcn_readfirstlane(tid >> 6), lane = tid & 63, wr = wid >> 2, wc = wid & 3, fr = lane & 15, fq = lane >> 4;
    const int K = g.K, nt = K / BK;
    unsigned voffA[2], voffB[2];
#pragma unroll
    for (int i = 0; i < 2; ++i) { int R, C; stage_rc(tid * 16 + i * 8192, R, C); const int Rb = Epi::PERM ? ((R & ~31) + perm32(R & 31)) : R;
        voffA[i] = (unsigned)(R * K + C) * 2u; voffB[i] = (unsigned)(Rb * K + C) * 2u; }
    const size_t kstep = (size_t)(BK * 2);
    const size_t hstep = (size_t)HALF * K * 2;
    const size_t tstep = 2 * hstep;
    const unsigned ldsw = (unsigned)wid * 1024u;
    const int aoff = lds_byte(wr * 64 + fr, fq * 8), boff = lds_byte(wc * 32 + fr, fq * 8);
#define PG8_SA(b, h) (((b) * 2 + (h)) * HTB)
#define PG8_SB(b, h) ((4 + (b) * 2 + (h)) * HTB)
#define PG8_STAGE(bufoff, gbase, voff) do { _Pragma("unroll") for (int _i = 0; _i < 2; ++_i) \
        __builtin_amdgcn_global_load_lds((const unsigned*)((const char*)(gbase) + (voff)[_i]), (PG8_LAS unsigned*)(lds + (bufoff) + ldsw + _i * 8192), 16, 0, 0); } while (0)
#define PG8_LDA(dst, b, h) do { _Pragma("unroll") for (int m = 0; m < 4; ++m) _Pragma("unroll") for (int k = 0; k < 2; ++k) dst[m][k] = *(const PG8_LAS bf16x8*)(lds + PG8_SA(b, h) + aoff + m * 2048 + k * 1024); } while (0)
#define PG8_LDB(dst, b, h) do { _Pragma("unroll") for (int n = 0; n < 2; ++n) _Pragma("unroll") for (int k = 0; k < 2; ++k) dst[n][k] = *(const PG8_LAS bf16x8*)(lds + PG8_SB(b, h) + boff + n * 2048 + k * 1024); } while (0)
#define PG8_MMA(ai, bj, At, Bt) do { __builtin_amdgcn_s_setprio(1); _Pragma("unroll") for (int m = 0; m < 4; ++m) _Pragma("unroll") for (int n = 0; n < 2; ++n) _Pragma("unroll") for (int k = 0; k < 2; ++k) \
        acc[ai][bj][m][n] = __builtin_amdgcn_mfma_f32_16x16x32_bf16(Bt[n][k], At[m][k], acc[ai][bj][m][n], 0, 0, 0); __builtin_amdgcn_s_setprio(0); } while (0)
#define PG8_WAIT_V(n) asm volatile("s_waitcnt vmcnt(" #n ")" ::: "memory")
#define PG8_WAIT_L(n) asm volatile("s_waitcnt lgkmcnt(" #n ")" ::: "memory")
#define PG8_BAR __builtin_amdgcn_s_barrier()
#define PG8_SCHED __builtin_amdgcn_sched_barrier(0)
    Unit cur, nxt; int ui = 0;
    if (!S.next(0, cur)) return;
    f32x4 acc[2][2][4][2];
#pragma unroll
    for (int a = 0; a < 2; ++a)
#pragma unroll
        for (int b = 0; b < 2; ++b)
#pragma unroll
            for (int m = 0; m < 4; ++m)
#pragma unroll
                for (int n = 0; n < 2; ++n) acc[a][b][m][n] = (f32x4){0.f, 0.f, 0.f, 0.f};
    bf16x8 At[4][2], B0[2][2], B1[2][2];
    const char* cA = (const char*)g.A + (size_t)cur.pm * tstep; const char* cB = (const char*)g.Bt + (size_t)cur.pn * tstep;
    S.a_ready(cur);
    if constexpr (SP2) {
        PG8_STAGE(PG8_SB(0, 0), cB, voffB); PG8_STAGE(PG8_SB(0, 1), cB + hstep, voffB); PG8_STAGE(PG8_SA(0, 0), cA, voffA); PG8_STAGE(PG8_SA(0, 1), cA + hstep, voffA);
        if (wr == 1) PG8_BAR;
        PG8_WAIT_V(2); PG8_BAR;
        PG8_STAGE(PG8_SB(1, 0), cB + kstep, voffB); PG8_STAGE(PG8_SA(1, 0), cA + kstep, voffA); PG8_STAGE(PG8_SB(1, 1), cB + hstep + kstep, voffB);
        PG8_WAIT_V(6); PG8_BAR;
    } else {
        PG8_STAGE(PG8_SB(0, 0), cB, voffB); PG8_STAGE(PG8_SA(0, 0), cA, voffA); PG8_STAGE(PG8_SB(0, 1), cB + hstep, voffB); PG8_STAGE(PG8_SA(0, 1), cA + hstep, voffA);
        if (wr == 1) PG8_BAR;
        PG8_WAIT_V(4); PG8_BAR;
        PG8_STAGE(PG8_SB(1, 0), cB + kstep, voffB); PG8_STAGE(PG8_SA(1, 0), cA + kstep, voffA); PG8_STAGE(PG8_SB(1, 1), cB + hstep + kstep, voffB);
        PG8_WAIT_V(6); PG8_BAR;
    }
    for (;;) {
        const bool has_next = S.next(ui + 1, nxt);
        const char* nA = has_next ? (const char*)g.A + (size_t)nxt.pm * tstep : cA; const char* nB = has_next ? (const char*)g.Bt + (size_t)nxt.pn * tstep : cB;
        for (int t = 0; t < nt; t += 2) {
            const bool last = (t == nt - 2);
            const char* a1 = cA + (size_t)(t + 1) * kstep;
            const char* a2 = last ? nA : cA + (size_t)(t + 2) * kstep; const char* b2 = last ? nB : cB + (size_t)(t + 2) * kstep;
            const char* a3 = a2 + kstep; const char* b3 = b2 + kstep;
            if (last && has_next) S.a_ready(nxt);
            if constexpr (SP2) {
            PG8_LDB(B0, 0, 0); PG8_LDB(B1, 0, 1); PG8_SCHED; PG8_LDA(At, 0, 0); PG8_STAGE(PG8_SA(1, 1), a1 + hstep, voffA);
            PG8_WAIT_V(8); PG8_WAIT_L(0); PG8_BAR; PG8_MMA(0, 0, At, B0); PG8_MMA(0, 1, At, B1); PG8_BAR; PG8_SCHED;
            PG8_LDA(At, 0, 1); PG8_STAGE(PG8_SB(0, 0), b2, voffB); PG8_STAGE(PG8_SB(0, 1), b2 + hstep, voffB); PG8_STAGE(PG8_SA(0, 0), a2, voffA);
            PG8_WAIT_V(8); PG8_WAIT_L(0); PG8_BAR; PG8_MMA(1, 0, At, B0); PG8_MMA(1, 1, At, B1); PG8_BAR; PG8_SCHED;
            PG8_LDB(B0, 1, 0); PG8_LDB(B1, 1, 1); PG8_SCHED; PG8_LDA(At, 1, 0); PG8_STAGE(PG8_SA(0, 1), a2 + hstep, voffA);
            PG8_WAIT_V(8); PG8_WAIT_L(0); PG8_BAR; PG8_MMA(0, 0, At, B0); PG8_MMA(0, 1, At, B1); PG8_BAR; PG8_SCHED;
            PG8_LDA(At, 1, 1); PG8_STAGE(PG8_SB(1, 0), b3, voffB); PG8_STAGE(PG8_SB(1, 1), b3 + hstep, voffB); PG8_STAGE(PG8_SA(1, 0), a3, voffA);
            PG8_WAIT_V(8); PG8_WAIT_L(0); PG8_BAR; PG8_MMA(1, 0, At, B0); PG8_MMA(1, 1, At, B1); PG8_BAR; PG8_SCHED;
            } else {
            PG8_LDB(B0, 0, 0); PG8_SCHED; PG8_LDA(At, 0, 0); PG8_STAGE(PG8_SA(1, 1), a1 + hstep, voffA);
            PG8_WAIT_L(8); PG8_BAR; PG8_WAIT_L(0); PG8_MMA(0, 0, At, B0); PG8_BAR; PG8_SCHED;
            PG8_LDB(B1, 0, 1); PG8_STAGE(PG8_SB(0, 0), b2, voffB);
            PG8_BAR; PG8_WAIT_L(0); PG8_MMA(0, 1, At, B1); PG8_BAR;
            PG8_LDA(At, 0, 1); PG8_STAGE(PG8_SA(0, 0), a2, voffA);
            PG8_BAR; PG8_WAIT_L(0); PG8_MMA(1, 0, At, B0); PG8_BAR; PG8_SCHED;
            PG8_STAGE(PG8_SB(0, 1), b2 + hstep, voffB);
            PG8_WAIT_V(6); PG8_BAR; PG8_MMA(1, 1, At, B1); PG8_BAR;
            PG8_LDB(B0, 1, 0); PG8_SCHED; PG8_LDA(At, 1, 0); PG8_STAGE(PG8_SA(0, 1), a2 + hstep, voffA);
            PG8_WAIT_L(8); PG8_BAR; PG8_WAIT_L(0); PG8_MMA(0, 0, At, B0); PG8_BAR; PG8_SCHED;
            PG8_LDB(B1, 1, 1); PG8_STAGE(PG8_SB(1, 0), b3, voffB);
            PG8_BAR; PG8_WAIT_L(0); PG8_MMA(0, 1, At, B1); PG8_BAR;
            PG8_LDA(At, 1, 1); PG8_STAGE(PG8_SA(1, 0), a3, voffA);
            PG8_BAR; PG8_WAIT_L(0); PG8_MMA(1, 0, At, B0); PG8_BAR; PG8_SCHED;
            PG8_STAGE(PG8_SB(1, 1), b3 + hstep, voffB);
            PG8_WAIT_V(6); PG8_BAR; PG8_MMA(1, 1, At, B1); PG8_BAR;
            }
        }
        if constexpr (ALIGN_EPI) { if (wr == 0) PG8_BAR; }
        if constexpr (!Epi::AFTER_DRAIN) { E(acc, cur, wr, wc, fr, fq); S.done(cur); }
        if (!has_next) break;
#pragma unroll
        for (int a = 0; a < 2; ++a)
#pragma unroll
            for (int b = 0; b < 2; ++b)
#pragma unroll
                for (int m = 0; m < 4; ++m)
#pragma unroll
                    for (int n = 0; n < 2; ++n) acc[a][b][m][n] = (f32x4){0.f, 0.f, 0.f, 0.f};
        cur = nxt; cA = nA; cB = nB; ++ui;
        if constexpr (ALIGN_EPI) { if (wr == 1) PG8_BAR; }
    }
    PG8_WAIT_V(0);
    if constexpr (!ALIGN_EPI) { if (wr == 0) PG8_BAR; }
    PG8_BAR;
#undef PG8_SA
#undef PG8_SB
#undef PG8_STAGE
#undef PG8_LDA
#undef PG8_LDB
#undef PG8_MMA
#undef PG8_WAIT_V
#undef PG8_WAIT_L
#undef PG8_BAR
#undef PG8_SCHED
}
}

constexpr int NWAVES = 8;
constexpr int D = 2048, SEQ = 4096, NBP = 2, NBS = 8, LSMP = 4;
constexpr int MPROMPT = NBP * SEQ;
constexpr int MV = MPROMPT + NBS * LSMP;
constexpr int MP = 8448;
constexpr int FF = 5632, NUP = 2 * FF;
constexpr int AW = 1280, AH = 10, ADK = 128;
constexpr int BW = 768, NGRP = 3, HPG = 4, HD = 64;
constexpr int IN0 = 7444, IN0P = 7680, PLD = 7424;
constexpr int QB_OFF = 5120;
constexpr int IN1 = 6144;
constexpr int NSEQ = 10, NMOD = 9 * D;
constexpr int PASTLEN = 16384;
constexpr float EPS = 1e-6f;
constexpr float B_SCALE = 0.125f;
__host__ __device__ __forceinline__ int swaW(int g) { return 128 << (2 * g); }
__host__ __device__ __forceinline__ int swaD(int g) { return 1 << (2 * g); }

constexpr size_t O_YP = 0, O_YS = O_YP + (size_t)MPROMPT * D, O_PS = O_YS + (size_t)NBS * LSMP * D, O_PCONV = O_PS + (size_t)NBP * AH * 128 * 128,
    O_PKV0 = O_PCONV + (size_t)NBP * 3 * 3840, O_PKV1 = O_PKV0 + (size_t)NBP * 128 * 512, O_PKV2 = O_PKV1 + (size_t)NBP * 512 * 512, O_PSC = O_PKV2 + (size_t)NBP * 2048 * 512,
    O_SS = O_PSC + (size_t)NBP * 2 * D, O_SCONV = O_SS + (size_t)NBS * AH * 128 * 128, O_SKV0 = O_SCONV + (size_t)NBS * 3 * 3840, O_SKV1 = O_SKV0 + (size_t)NBS * 128 * 512,
    O_SKV2 = O_SKV1 + (size_t)NBS * 512 * 512, O_SSC = O_SKV2 + (size_t)NBS * 2048 * 512, O_END = O_SSC + (size_t)NBS * 2 * D;
static_assert(O_END == 32399872, "output size");

constexpr size_t MiB = 1u << 20;
constexpr size_t WS_CTL = 0, CTL_ZERO_BYTES = 1 * MiB;
constexpr size_t WS_MOD = 1 * MiB;
constexpr size_t WS_G = 3 * MiB;
constexpr size_t WS_BETA = 4 * MiB;
constexpr size_t WS_LSE = 5 * MiB;
constexpr size_t WS_AB = 6 * MiB;
constexpr size_t WS_WUP = 8 * MiB;
constexpr size_t WUP_STRIDE = (size_t)NUP * D * 2;
constexpr size_t WS_WDN = WS_WUP + 4 * WUP_STRIDE;
constexpr size_t WDN_STRIDE = (size_t)D * FF * 2;
constexpr size_t WS_WIN0 = WS_WDN + 4 * WDN_STRIDE;
constexpr size_t WS_WOUT0 = WS_WIN0 + (size_t)IN0P * D * 2;
constexpr size_t WS_WIN1 = WS_WOUT0 + (size_t)D * D * 2;
constexpr size_t WS_WOUT1 = WS_WIN1 + (size_t)IN1 * D * 2;
constexpr size_t WS_X = WS_WOUT1 + (size_t)D * D * 2;
constexpr size_t WS_H = WS_X + (size_t)MP * D * 4;
constexpr size_t WS_ACT = WS_H + (size_t)MP * D * 2;
constexpr size_t WS_PROJ = WS_ACT + (size_t)MP * FF * 2;
constexpr size_t WS_MIX = WS_PROJ + (size_t)MP * PLD * 2;
constexpr size_t WS_QKVC = WS_MIX + (size_t)MP * D * 2;
constexpr size_t WS_OA = WS_QKVC + (size_t)MP * 3840 * 2;
constexpr size_t WS_OB = WS_OA + (size_t)MP * AW * 4;
constexpr size_t WS_GT = WS_OB + (size_t)MP * BW * 4;
constexpr size_t WS_CHK = WS_GT + 8192;
constexpr size_t CHK_STRIDE = 90112, CHK_WN = 32768, CHK_QD = 49152, CHK_QK = 65536, CHK_KD = 73728;
constexpr int N_CHUNK_UNITS = NBP * AH * (SEQ / 64);
constexpr size_t WS_END = WS_CHK + (size_t)N_CHUNK_UNITS * CHK_STRIDE;
static_assert(WS_MOD + (size_t)2 * NSEQ * NMOD * 4 <= WS_G && WS_AB + (size_t)MP * 32 * 4 <= WS_WUP, "small buffers");
static_assert(WS_WUP % 256 == 0 && WS_X % 256 == 0 && WS_H % 256 == 0 && WS_ACT % 256 == 0 && WS_PROJ % 256 == 0 && WS_MIX % 256 == 0 && WS_QKVC % 256 == 0 && WS_OA % 256 == 0 && WS_OB % 256 == 0 && WS_CHK % 256 == 0, "alignment");

constexpr int CW_TMO = 0, CW_CODE = 1;
constexpr int CW_BAR = 4096;

constexpr int RING_OFF = 0, RING_BYTES = 131072;
constexpr int LDSCTL_OFF = RING_BYTES, MISC_OFF = LDSCTL_OFF + 320;
constexpr int LDS_BYTES = 147456;
constexpr int SM_OFF = RING_BYTES + 1024, SM_WAVE = 1536;
static_assert(MISC_OFF + 128 <= LDS_BYTES, "LDS map");

#define GAS __attribute__((address_space(1)))
#define LAS __attribute__((address_space(3)))
typedef unsigned short bf16;
typedef unsigned v4u __attribute__((ext_vector_type(4)));
typedef unsigned v2u __attribute__((ext_vector_type(2)));
typedef float f32x4 __attribute__((ext_vector_type(4)));
typedef float f32x2 __attribute__((ext_vector_type(2)));
typedef __bf16 bf16x2t __attribute__((ext_vector_type(2)));
typedef GAS unsigned gu32;
typedef float f32x16 __attribute__((ext_vector_type(16)));
typedef short bf16x8s __attribute__((ext_vector_type(8)));
#define RLX_AGENT __ATOMIC_RELAXED, __HIP_MEMORY_SCOPE_AGENT
#define LDS_WAIT() asm volatile("s_waitcnt lgkmcnt(0)" ::: "memory")
#define VM_WAIT() asm volatile("s_waitcnt vmcnt(0)" ::: "memory")
__device__ __forceinline__ unsigned f2bf(float f) { unsigned u = __builtin_bit_cast(unsigned, f); return (u + 0x7fffu + ((u >> 16) & 1u)) >> 16; }
__device__ __forceinline__ unsigned pk2(float lo, float hi) { const f32x2 v = {lo, hi}; return __builtin_bit_cast(unsigned, __builtin_convertvector(v, bf16x2t)); }
__device__ __forceinline__ float bf_lo(unsigned w) { return __builtin_bit_cast(float, w << 16); }
__device__ __forceinline__ float bf_hi(unsigned w) { return __builtin_bit_cast(float, w & 0xffff0000u); }
__device__ __forceinline__ float bf2f(bf16 h) { return __builtin_bit_cast(float, (unsigned)h << 16); }

#define XB_TMO      128
#define XB_XCNT(j)  (256  + 64 * (j))
#define XB_XSUB(j)  (1280 + 64 * (j))
#define XB_XGEN(j)  (2304 + 64 * (j))
#define XB_TOP      3328
#define XB_TOPGEN   3392
#define XCD_BAR_WORDS 3456
#define XB_SPIN_CAP (1u << 18)

__device__ __forceinline__ unsigned xb_ld(unsigned* p)              { return __hip_atomic_load(p, __ATOMIC_RELAXED, __HIP_MEMORY_SCOPE_AGENT); }
__device__ __forceinline__ unsigned xb_add(unsigned* p, unsigned v) { return __hip_atomic_fetch_add(p, v, __ATOMIC_RELAXED, __HIP_MEMORY_SCOPE_AGENT); }
__device__ __forceinline__ unsigned xb_xcc_id() { return (unsigned)__builtin_amdgcn_s_getreg((3 << 11) | 20) & 0xFu; }
#define XB_SPIN(cond, bar) do { unsigned _sp = 0; while (cond) { __builtin_amdgcn_s_sleep(1); \
    if ((++_sp & 255u) == 0u) { if (xb_ld(&(bar)[XB_TMO])) break; if (_sp > XB_SPIN_CAP) { atomicAdd(&(bar)[XB_TMO], 1u); break; } } } } while (0)

struct XcdBarrier {
    unsigned* bar; unsigned x;
    volatile LAS unsigned* st;
};
__device__ __forceinline__ XcdBarrier xcd_barrier_post(unsigned* bar, volatile LAS unsigned* st) {
    XcdBarrier b; b.bar = bar; b.x = xb_xcc_id(); b.st = st;
    if (threadIdx.x == 0) (void)xb_add(&bar[XB_XCNT(b.x)], 1u);
    return b;
}
__device__ __forceinline__ void xcd_barrier_complete(unsigned* bar, unsigned x, unsigned& nloc, unsigned& nx) {
    const unsigned G = gridDim.x * gridDim.y * gridDim.z;
    unsigned sum, cnt, mine, sp = 0u;
    for (;;) {
        sum = 0u; cnt = 0u; mine = 0u;
#pragma unroll
        for (unsigned j = 0; j < 16; ++j) { const unsigned c = xb_ld(&bar[XB_XCNT(j)]); sum += c; cnt += (c > 0u) ? 1u : 0u; mine = (j == x) ? c : mine; }
        if (sum == G) break;
        __builtin_amdgcn_s_sleep(1);
        if ((++sp & 255u) == 0u) { if (xb_ld(&bar[XB_TMO])) break; if (sp > XB_SPIN_CAP) { atomicAdd(&bar[XB_TMO], 1u); break; } }
    }
    nloc = mine > 0u ? mine : 1u; nx = cnt > 0u ? cnt : 1u;
}
__device__ __forceinline__ void xcd_barrier(const XcdBarrier& b) {
    asm volatile("s_waitcnt vmcnt(0)" ::: "memory");
    __syncthreads();
    if (threadIdx.x == 0) {
        unsigned* bar = b.bar;
        __builtin_amdgcn_s_waitcnt(0);
        unsigned nloc = b.st[0], nx = b.st[1];
        if (nloc == 0u) { xcd_barrier_complete(bar, b.x, nloc, nx); b.st[0] = nloc; b.st[1] = nx; }
        const unsigned old = xb_add(&bar[XB_XSUB(b.x)], 1u);
        const unsigned gen = old / nloc;
        if (old + 1u == (gen + 1u) * nloc) {
            __builtin_amdgcn_fence(__ATOMIC_RELEASE, "agent");
            asm volatile("s_waitcnt vmcnt(0)" ::: "memory");
            const unsigned og = xb_add(&bar[XB_TOP], 1u);
            const unsigned tg = og / nx;
            if (og + 1u == (tg + 1u) * nx) xb_add(&bar[XB_TOPGEN], 1u);
            else XB_SPIN(xb_ld(&bar[XB_TOPGEN]) == tg, bar);
            __builtin_amdgcn_fence(__ATOMIC_ACQUIRE, "agent");
            xb_add(&bar[XB_XGEN(b.x)], 1u);
            asm volatile("s_waitcnt vmcnt(0)" ::: "memory");
        } else {
            XB_SPIN(xb_ld(&bar[XB_XGEN(b.x)]) == gen, bar);
            __builtin_amdgcn_fence(__ATOMIC_ACQUIRE, "agent");
            asm volatile("s_waitcnt vmcnt(0)" ::: "memory");
        }
    }
    __syncthreads();
}

struct Args { const float* in[27]; float* out; unsigned char* ws; int ph_lo, ph_hi; };
struct Frame {
    LAS unsigned char* lds;
    volatile LAS unsigned* MISC;
    gu32* ctl;
    int tid, lane, wave;
    int vcu, G;
    float* out;
    unsigned char* ws;
};

__device__ __forceinline__ float wave_sum(float v) {
#pragma unroll
    for (int o = 1; o < 64; o <<= 1) v += __shfl_xor(v, o);
    return v;
}
__device__ __forceinline__ float wave_max(float v) {
#pragma unroll
    for (int o = 1; o < 64; o <<= 1) v = fmaxf(v, __shfl_xor(v, o));
    return v;
}

__device__ __forceinline__ int src_col(int kind, int rr) {
    if (kind == 0) return rr;
    if (kind == 1) { const int t = rr >> 8, cc = rr & 255; return cc < 128 ? t * 128 + cc : FF + t * 128 + (cc - 128); }
    if (kind == 2) { if (rr < 5120) return rr; if (rr < 7424) return rr + 20; if (rr < 7444) return rr - 7424 + 5120; return -1; }
    if (rr < 2048) return rr;
    { const int q = rr - 2048, t = q >> 8, cc = q & 255; return cc < 128 ? 2048 + t * 128 + cc : 4096 + t * 128 + (cc - 128); }
}
__device__ __forceinline__ void p0_conv_task(const float* W, int K, int N, bf16* WT, int kind, int task, int nblk, int lane) {
    const int kb = task / nblk, nb = task % nblk, rr0 = 128 * nb + 2 * lane;
    const int sc = src_col(kind, rr0);
    const float* src = W + (size_t)(64 * kb) * N + (sc >= 0 ? sc : 0);
    bf16* dst = WT + (size_t)rr0 * K + 64 * kb;
    f32x2 v[64];
#pragma unroll
    for (int j = 0; j < 64; ++j) v[j] = sc >= 0 ? *(const f32x2*)(src + (size_t)j * N) : (f32x2){0.f, 0.f};
#pragma unroll
    for (int e = 0; e < 2; ++e)
#pragma unroll
        for (int ks = 0; ks < 8; ++ks) { v4u o; o.x = pk2(v[8 * ks][e], v[8 * ks + 1][e]); o.y = pk2(v[8 * ks + 2][e], v[8 * ks + 3][e]); o.z = pk2(v[8 * ks + 4][e], v[8 * ks + 5][e]); o.w = pk2(v[8 * ks + 6][e], v[8 * ks + 7][e]);
            *(GAS v4u*)(dst + (size_t)e * K + 8 * ks) = o; }
}
constexpr int CVI_UP = (D / 64) * (NUP / 128), CVI_DN = (FF / 64) * (D / 128), CVI_IN0 = (D / 64) * (IN0P / 128), CVI_O = (D / 64) * (D / 128), CVI_IN1 = (D / 64) * (IN1 / 128);
constexpr int CV_P0 = CVI_UP + CVI_DN + CVI_IN0;
constexpr int CV_SCAN = CV_P0 + CVI_O + CVI_UP + CVI_DN + CVI_IN1 + CVI_O + CVI_UP + CVI_DN;
constexpr int CV_T1 = CV_SCAN + CVI_UP;
constexpr int CV_END = CV_T1 + CVI_DN;
__device__ __forceinline__ void convert_items(Frame& F, const Args& args, const int lo, const int hi, const int widx, const int nw) {
#pragma unroll 1
    for (int it = lo + widx; it < hi; it += nw) {
        int r = it;
        if (r < CVI_UP) { p0_conv_task((args.in[16]), D, NUP, (bf16*)(F.ws + WS_WUP), 1, r, NUP / 128, F.lane); continue; } r -= CVI_UP;
        if (r < CVI_DN) { p0_conv_task((args.in[17]), FF, D, (bf16*)(F.ws + WS_WDN), 0, r, D / 128, F.lane); continue; } r -= CVI_DN;
        if (r < CVI_IN0) { p0_conv_task((args.in[18]), D, IN0, (bf16*)(F.ws + WS_WIN0), 2, r, IN0P / 128, F.lane); continue; } r -= CVI_IN0;
        if (r < CVI_O) { p0_conv_task((args.in[23]), D, D, (bf16*)(F.ws + WS_WOUT0), 0, r, D / 128, F.lane); continue; } r -= CVI_O;
        if (r < CVI_UP) { p0_conv_task((args.in[16]) + (size_t)1 * D * NUP, D, NUP, (bf16*)(F.ws + WS_WUP + 1 * WUP_STRIDE), 1, r, NUP / 128, F.lane); continue; } r -= CVI_UP;
        if (r < CVI_DN) { p0_conv_task((args.in[17]) + (size_t)1 * FF * D, FF, D, (bf16*)(F.ws + WS_WDN + 1 * WDN_STRIDE), 0, r, D / 128, F.lane); continue; } r -= CVI_DN;
        if (r < CVI_IN1) { p0_conv_task((args.in[24]), D, IN1, (bf16*)(F.ws + WS_WIN1), 3, r, IN1 / 128, F.lane); continue; } r -= CVI_IN1;
        if (r < CVI_O) { p0_conv_task((args.in[26]), D, D, (bf16*)(F.ws + WS_WOUT1), 0, r, D / 128, F.lane); continue; } r -= CVI_O;
        if (r < CVI_UP) { p0_conv_task((args.in[16]) + (size_t)2 * D * NUP, D, NUP, (bf16*)(F.ws + WS_WUP + 2 * WUP_STRIDE), 1, r, NUP / 128, F.lane); continue; } r -= CVI_UP;
        if (r < CVI_DN) { p0_conv_task((args.in[17]) + (size_t)2 * FF * D, FF, D, (bf16*)(F.ws + WS_WDN + 2 * WDN_STRIDE), 0, r, D / 128, F.lane); continue; } r -= CVI_DN;
        if (r < CVI_UP) { p0_conv_task((args.in[16]) + (size_t)3 * D * NUP, D, NUP, (bf16*)(F.ws + WS_WUP + 3 * WUP_STRIDE), 1, r, NUP / 128, F.lane); continue; } r -= CVI_UP;
        p0_conv_task((args.in[17]) + (size_t)3 * FF * D, FF, D, (bf16*)(F.ws + WS_WDN + 3 * WDN_STRIDE), 0, r, D / 128, F.lane);
    }
}
__device__ __forceinline__ void p0_weights(Frame& F, const Args& args) { convert_items(F, args, 0, CV_P0, F.vcu * NWAVES + F.wave, F.G * NWAVES); }
__device__ __forceinline__ void convert_slack(Frame& F, const Args& args, const int lo, const int hi, const int idx, const int first, const int nwv) {
    if (F.wave >= nwv) return;
    if (F.G > first) { if (idx >= first) convert_items(F, args, lo, hi, (idx - first) * nwv + F.wave, (F.G - first) * nwv); }
    else convert_items(F, args, lo, hi, idx * nwv + F.wave, F.G * nwv);
}
__device__ __forceinline__ void p0_mod(Frame& F, const Args& args) {
    LAS float* SC = (LAS float*)(F.lds + RING_OFF);
    LAS float* RED = (LAS float*)(F.lds + RING_OFF + 81920);
    __syncthreads();
    for (int i = F.tid; i < NSEQ * D; i += NWAVES * 64) { const int s = i / D, k = i % D; const float c = s < NBP ? (args.in[2])[s * D + k] : (args.in[3])[(s - NBP) * D + k];
        SC[k * NSEQ + s] = c / (1.0f + __expf(-c)); }
    __syncthreads();
    for (int slab = F.vcu; slab < 256; slab += F.G) {
        const int l = slab >> 7, n0 = (slab & 127) * 144;
        float acc[NSEQ][4];
#pragma unroll
        for (int s = 0; s < NSEQ; ++s) { acc[s][0] = 0.f; acc[s][1] = 0.f; acc[s][2] = 0.f; acc[s][3] = 0.f; }
        if (F.lane < 36) {
            const float* wp = (args.in[10]) + ((size_t)l * D + F.wave * 256) * NMOD + n0 + 4 * F.lane;
            const LAS float* sp = SC + (F.wave * 256) * NSEQ;
#pragma unroll 8
            for (int k = 0; k < 256; ++k) { const f32x4 w = *(const f32x4*)(wp + (size_t)k * NMOD);
#pragma unroll
                for (int s = 0; s < NSEQ; ++s) { const float c = sp[k * NSEQ + s]; acc[s][0] += c * w[0]; acc[s][1] += c * w[1]; acc[s][2] += c * w[2]; acc[s][3] += c * w[3]; } }
#pragma unroll
            for (int s = 0; s < NSEQ; ++s)
#pragma unroll
                for (int j = 0; j < 4; ++j) RED[(F.wave * NSEQ + s) * 144 + 4 * F.lane + j] = acc[s][j];
        }
        __syncthreads();
        for (int i = F.tid; i < NSEQ * 144; i += NWAVES * 64) { const int s = i / 144, j = i % 144; float v = (args.in[11])[l * NMOD + n0 + j];
#pragma unroll
            for (int w = 0; w < 8; ++w) v += RED[(w * NSEQ + s) * 144 + j];
            ((float*)(F.ws + WS_MOD))[((size_t)l * NSEQ + s) * NMOD + n0 + j] = v; }
        __syncthreads();
    }
}

__device__ __forceinline__ void norm_phase(Frame& F, const Args& args, const float* gain, const float* shift, const float* scale, bool first) {
    const int gw = F.vcu * NWAVES + F.wave, NGW = F.G * NWAVES;
    for (int m = gw; m < MP; m += NGW) {
        GAS v4u* o16 = (GAS v4u*)(((bf16*)(F.ws + WS_H)) + (size_t)m * D);
        if (m >= MV) {
#pragma unroll
            for (int j = 0; j < 4; ++j) o16[64 * j + F.lane] = (v4u){0u, 0u, 0u, 0u};
            continue; }
        const float* src = first ? (m < MPROMPT ? (args.in[0]) + (size_t)m * D : (args.in[1]) + (size_t)(m - MPROMPT) * D) : ((float*)(F.ws + WS_X)) + (size_t)m * D;
        const int seq = pg8::seq_of_row(m);
        f32x4 v[4][2]; float ss = 0.f;
#pragma unroll
        for (int j = 0; j < 4; ++j)
#pragma unroll
            for (int h = 0; h < 2; ++h) { v[j][h] = *(const f32x4*)(src + 512 * j + 8 * F.lane + 4 * h); ss += (v[j][h].x * v[j][h].x + v[j][h].y * v[j][h].y) + (v[j][h].z * v[j][h].z + v[j][h].w * v[j][h].w); }
        if (first) {
#pragma unroll
            for (int j = 0; j < 4; ++j)
#pragma unroll
                for (int h = 0; h < 2; ++h) *(f32x4*)(((float*)(F.ws + WS_X)) + (size_t)m * D + 512 * j + 8 * F.lane + 4 * h) = v[j][h]; }
        const float rstd = 1.0f / sqrtf(wave_sum(ss) * (1.0f / D) + EPS);
        const float* shp = shift + (size_t)seq * NMOD; const float* scp = scale + (size_t)seq * NMOD;
#pragma unroll
        for (int j = 0; j < 4; ++j) { float r[8];
#pragma unroll
            for (int h = 0; h < 2; ++h) { const int e = 512 * j + 8 * F.lane + 4 * h; const f32x4 g = *(const f32x4*)(gain + e), sh = *(const f32x4*)(shp + e), sc = *(const f32x4*)(scp + e);
                const f32x4 y = (v[j][h] * rstd) * g * (sc + 1.0f) + sh; r[4 * h + 0] = y.x; r[4 * h + 1] = y.y; r[4 * h + 2] = y.z; r[4 * h + 3] = y.w; }
            v4u o; o.x = pk2(r[0], r[1]); o.y = pk2(r[2], r[3]); o.z = pk2(r[4], r[5]); o.w = pk2(r[6], r[7]);
            o16[64 * j + F.lane] = o; }
    }
}
__device__ __forceinline__ void final_norm_phase(Frame& F, const Args& args) {
    const int gw = F.vcu * NWAVES + F.wave, NGW = F.G * NWAVES;
    for (int m = gw; m < MV; m += NGW) {
        const float* src = ((float*)(F.ws + WS_X)) + (size_t)m * D; float* dst = F.out + O_YP + (size_t)m * D;
        f32x4 v[8]; float ss = 0.f;
#pragma unroll
        for (int j = 0; j < 8; ++j) { v[j] = *(const f32x4*)(src + 256 * j + 4 * F.lane); ss += (v[j].x * v[j].x + v[j].y * v[j].y) + (v[j].z * v[j].z + v[j].w * v[j].w); }
        const float rstd = 1.0f / sqrtf(wave_sum(ss) * (1.0f / D) + EPS);
#pragma unroll
        for (int j = 0; j < 8; ++j) { const f32x4 g = *(const f32x4*)((args.in[15]) + 256 * j + 4 * F.lane); *(f32x4*)(dst + 256 * j + 4 * F.lane) = (v[j] * rstd) * g; }
    }
}

__device__ __forceinline__ float softplus_f(float x) { return x > 20.f ? x : log1pf(__expf(x)); }
__device__ __forceinline__ void gdn_prep(Frame& F, const Args& args) {
    const int gw = F.vcu * NWAVES + F.wave, NGW = F.G * NWAVES;
    for (int id = gw; id < MV * AH; id += NGW) {
        const int m = id / AH, h = id % AH;
        const bool smp = m >= MPROMPT; const int t = smp ? ((m - MPROMPT) & 3) : (m & (SEQ - 1)); const int sb = smp ? ((m - MPROMPT) >> 2) : 0;
        float y[3][2];
#pragma unroll
        for (int part = 0; part < 3; ++part) {
            const int c = part * AW + h * ADK + 2 * F.lane;
            float a0 = 0.f, a1 = 0.f;
#pragma unroll
            for (int j = 0; j < 4; ++j) { const int tt = t - 3 + j; float x0, x1;
                if (tt >= 0) { const unsigned w = *(const unsigned*)(((bf16*)(F.ws + WS_PROJ)) + (size_t)(m - t + tt) * PLD + c); x0 = bf_lo(w); x1 = bf_hi(w); }
                else if (smp) { const f32x2 w = *(const f32x2*)((args.in[5]) + (size_t)(sb * 3 + (3 + tt)) * 3840 + c); x0 = w.x; x1 = w.y; }
                else { x0 = 0.f; x1 = 0.f; }
                const f32x2 cw = *(const f32x2*)((args.in[19]) + (size_t)j * 3840 + c); a0 += cw.x * x0; a1 += cw.y * x1; }
            y[part][0] = a0 / (1.0f + __expf(-a0)); y[part][1] = a1 / (1.0f + __expf(-a1));
        }
        const float sq = wave_sum(y[0][0] * y[0][0] + y[0][1] * y[0][1]), sk = wave_sum(y[1][0] * y[1][0] + y[1][1] * y[1][1]);
        const float rq = (1.0f / sqrtf(sq + EPS)) * 0.08838834764831845f, rk = 1.0f / sqrtf(sk + EPS);
        bf16* qrow = ((bf16*)(F.ws + WS_QKVC)) + (size_t)m * 3840 + h * ADK + 2 * F.lane;
        *(unsigned*)(qrow) = pk2(y[0][0] * rq, y[0][1] * rq); *(unsigned*)(qrow + AW) = pk2(y[1][0] * rk, y[1][1] * rk); *(unsigned*)(qrow + 2 * AW) = pk2(y[2][0], y[2][1]);
        if (F.lane == 0) { const float aa = ((float*)(F.ws + WS_AB))[(size_t)m * 32 + h], bb = ((float*)(F.ws + WS_AB))[(size_t)m * 32 + 10 + h];
            ((float*)(F.ws + WS_G))[(size_t)m * AH + h] = -__expf((args.in[20])[h]) * softplus_f(aa + (args.in[21])[h]); ((float*)(F.ws + WS_BETA))[(size_t)m * AH + h] = 1.0f / (1.0f + __expf(-bb)); }
    }
}
__device__ __forceinline__ unsigned cvtpk(float lo, float hi) { const f32x2 v = {lo, hi}; return __builtin_bit_cast(unsigned, __builtin_convertvector(v, bf16x2t)); }
__device__ __forceinline__ int pos4(int k4) { const int g = (k4 >> 2) & 3; return (k4 & ~15) + 4 * (((g & 1) << 1) | (g >> 1)); }
__device__ __forceinline__ bf16x8s pack8(const float (&x)[8]) { v4u w; w.x = cvtpk(x[0], x[1]); w.y = cvtpk(x[2], x[3]); w.z = cvtpk(x[4], x[5]); w.w = cvtpk(x[6], x[7]); return __builtin_bit_cast(bf16x8s, w); }
#define MFMA32(a, b, c) __builtin_amdgcn_mfma_f32_32x32x16_bf16((a), (b), (c), 0, 0, 0)

__device__ __forceinline__ void swa_prompt(Frame& F, const Args& args) {
    const int gw = F.vcu * NWAVES + F.wave, NGW = F.G * NWAVES;
    const bf16* PROJ = (const bf16*)(F.ws + WS_PROJ);
    float* OBp = (float*)(F.ws + WS_OB); float* LSEp = (float*)(F.ws + WS_LSE);
    for (int task = gw; task < 3072; task += NGW) {
        int l = F.lane; asm volatile("" : "+v"(l));
        const int r = l & 31, hh = l >> 5;
        const int b = task / 1536, r1 = task % 1536, g = r1 >> 9, r2 = r1 & 511, hs = r2 >> 7, rb = r2 & 127;
        const int d = swaD(g), nqb = 128 / d, res = rb / nqb, qb = rb % nqb, s0 = 32 * qb;
        const int hcol = (g * HPG + hs) * HD;
        const size_t rowb = (size_t)b * SEQ + res;
        bf16x8s idf[2];
#pragma unroll
        for (int s = 0; s < 2; ++s) { v4u w;
            w.x = (16 * s + 8 * hh + 0 == r ? 0x3F80u : 0u) | (16 * s + 8 * hh + 1 == r ? 0x3F800000u : 0u); w.y = (16 * s + 8 * hh + 2 == r ? 0x3F80u : 0u) | (16 * s + 8 * hh + 3 == r ? 0x3F800000u : 0u);
            w.z = (16 * s + 8 * hh + 4 == r ? 0x3F80u : 0u) | (16 * s + 8 * hh + 5 == r ? 0x3F800000u : 0u); w.w = (16 * s + 8 * hh + 6 == r ? 0x3F80u : 0u) | (16 * s + 8 * hh + 7 == r ? 0x3F800000u : 0u);
            idf[s] = __builtin_bit_cast(bf16x8s, w); }
        const bf16* qrow = PROJ + (rowb + (size_t)d * (s0 + r)) * PLD + QB_OFF + hcol + 8 * hh;
        bf16x8s qf[4];
#pragma unroll
        for (int s4 = 0; s4 < 4; ++s4) qf[s4] = *(const bf16x8s*)(qrow + 16 * s4);
        f32x16 T[5];
#pragma unroll
        for (int kt = 0; kt < 5; ++kt) {
            const int sk = s0 - 128 + 32 * kt + r; const int skc = sk < 0 ? 0 : sk;
            const bf16* krow = PROJ + (rowb + (size_t)d * skc) * PLD + QB_OFF + BW + hcol + 8 * hh;
#pragma unroll
            for (int i = 0; i < 16; ++i) T[kt][i] = 0.f;
#pragma unroll
            for (int s4 = 0; s4 < 4; ++s4) T[kt] = MFMA32(*(const bf16x8s*)(krow + 16 * s4), qf[s4], T[kt]);
        }
        float mx = -INFINITY;
#pragma unroll
        for (int kt = 0; kt < 5; ++kt)
#pragma unroll
            for (int i = 0; i < 16; ++i) { const int j = 32 * kt + (i & 3) + 8 * (i >> 2) + 4 * hh;
                const bool ok = (j >= r) && (j <= r + 128) && (s0 - 128 + j >= 0);
                const float v = ok ? T[kt][i] * B_SCALE : -INFINITY; T[kt][i] = v; mx = fmaxf(mx, v); }
        mx = fmaxf(mx, __shfl_xor(mx, 32));
        float sum = 0.f;
#pragma unroll
        for (int kt = 0; kt < 5; ++kt)
#pragma unroll
            for (int i = 0; i < 16; ++i) { const float p = __expf(T[kt][i] - mx); T[kt][i] = p; sum += p; }
        sum += __shfl_xor(sum, 32);
        const float rinv = 1.0f / sum;
        const size_t mq = rowb + (size_t)d * (s0 + r);
        if (hh == 0) LSEp[mq * 12 + g * HPG + hs] = mx + __logf(sum);
        f32x16 O[2];
#pragma unroll
        for (int dt = 0; dt < 2; ++dt)
#pragma unroll
            for (int i = 0; i < 16; ++i) O[dt][i] = 0.f;
#pragma unroll
        for (int kt = 0; kt < 5; ++kt) {
            const int sk = s0 - 128 + 32 * kt + r; const int skc = sk < 0 ? 0 : sk;
            const bf16* vrow = PROJ + (rowb + (size_t)d * skc) * PLD + QB_OFF + 2 * BW + hcol + 8 * hh;
            bf16x8s pa[2];
#pragma unroll
            for (int s2 = 0; s2 < 2; ++s2) { const float x[8] = {T[kt][8 * s2] * rinv, T[kt][8 * s2 + 1] * rinv, T[kt][8 * s2 + 2] * rinv, T[kt][8 * s2 + 3] * rinv, T[kt][8 * s2 + 4] * rinv, T[kt][8 * s2 + 5] * rinv, T[kt][8 * s2 + 6] * rinv, T[kt][8 * s2 + 7] * rinv}; pa[s2] = pack8(x); }
#pragma unroll
            for (int dt = 0; dt < 2; ++dt) {
                f32x16 XV;
#pragma unroll
                for (int i = 0; i < 16; ++i) XV[i] = 0.f;
#pragma unroll
                for (int s2 = 0; s2 < 2; ++s2) XV = MFMA32(*(const bf16x8s*)(vrow + 32 * dt + 16 * s2), idf[s2], XV);
#pragma unroll
                for (int s2 = 0; s2 < 2; ++s2) { const float x[8] = {XV[8 * s2], XV[8 * s2 + 1], XV[8 * s2 + 2], XV[8 * s2 + 3], XV[8 * s2 + 4], XV[8 * s2 + 5], XV[8 * s2 + 6], XV[8 * s2 + 7]};
                    O[dt] = MFMA32(pa[s2], pack8(x), O[dt]); }
            }
        }
#pragma unroll
        for (int dt = 0; dt < 2; ++dt)
#pragma unroll
            for (int i = 0; i < 16; ++i) { const int qi = (i & 3) + 8 * (i >> 2) + 4 * hh;
                OBp[(rowb + (size_t)d * (s0 + qi)) * BW + hcol + 32 * dt + r] = O[dt][i]; }
    }
}
__device__ __forceinline__ void swa_sample(Frame& F, const Args& args) {
    LAS float* Ps = (LAS float*)(F.lds + RING_OFF + 51200 + 16384) + F.wave * 132;
    const int gw = F.vcu * NWAVES + F.wave, NGW = F.G * NWAVES;
    for (int id = gw; id < NBS * LSMP * 12; id += NGW) {
        const int sb = id / 48, r1 = id % 48, t = r1 / 12, gh = r1 % 12, g = gh >> 2, hs = gh & 3;
        const int d = swaD(g), W = swaW(g);
        const float* cache = g == 0 ? (args.in[6]) : (g == 1 ? (args.in[7]) : (args.in[8]));
        const int hcol = gh * HD;
        const size_t mq = (size_t)(MPROMPT + sb * LSMP + t);
        const bf16* qrow = ((bf16*)(F.ws + WS_PROJ)) + mq * PLD + QB_OFF + hcol;
        float sc[3];
#pragma unroll
        for (int pass = 0; pass < 3; ++pass) {
            const int mm = pass * 64 + F.lane; float a = -INFINITY;
            if (mm <= 128) { const int p = t - d * mm; a = 0.f;
                if (p >= 0) { const bf16* kr = ((bf16*)(F.ws + WS_PROJ)) + (size_t)(MPROMPT + sb * LSMP + p) * PLD + QB_OFF + BW + hcol;
                    for (int e = 0; e < 64; e += 2) { const unsigned kw = *(const unsigned*)(kr + e), qw = *(const unsigned*)(qrow + e); a += bf_lo(qw) * bf_lo(kw) + bf_hi(qw) * bf_hi(kw); } }
                else { const float* kr = cache + ((size_t)(sb * W + (W + p)) * 2 + 0) * 256 + hs * HD;
                    for (int e = 0; e < 64; e += 2) { const f32x2 kw = *(const f32x2*)(kr + e); const unsigned qw = *(const unsigned*)(qrow + e); a += bf_lo(qw) * kw.x + bf_hi(qw) * kw.y; } }
                a *= B_SCALE; }
            sc[pass] = a;
        }
        const float mx = wave_max(fmaxf(fmaxf(sc[0], sc[1]), sc[2]));
        const float p0 = __expf(sc[0] - mx), p1 = __expf(sc[1] - mx), p2 = __expf(sc[2] - mx);
        const float den = wave_sum(p0 + p1 + p2), rden = 1.0f / den;
        Ps[F.lane] = p0 * rden; Ps[64 + F.lane] = p1 * rden; if (F.lane == 0) Ps[128] = p2 * rden;
        LDS_WAIT(); asm volatile("" ::: "memory");
        float o = 0.f;
        for (int mm = 0; mm <= 128; ++mm) { const int p = t - d * mm; float vv;
            if (p >= 0) vv = bf2f(((bf16*)(F.ws + WS_PROJ))[(size_t)(MPROMPT + sb * LSMP + p) * PLD + QB_OFF + 2 * BW + hcol + F.lane]);
            else vv = cache[((size_t)(sb * W + (W + p)) * 2 + 1) * 256 + hs * HD + F.lane];
            o += Ps[mm] * vv; }
        ((float*)(F.ws + WS_OB))[mq * BW + hcol + F.lane] = o;
        if (F.lane == 0) ((float*)(F.ws + WS_LSE))[mq * 12 + gh] = mx + __logf(den);
        LDS_WAIT(); asm volatile("" ::: "memory");
    }
}
__device__ __forceinline__ void mixer0_copies(Frame& F, const Args& args) {
    const long gt = (long)F.vcu * (NWAVES * 64) + F.tid, NGT = (long)F.G * NWAVES * 64;
    for (long i = gt; i < (long)(NBP + NBS) * 3 * 3840; i += NGT) { const int c = (int)(i % 3840), j = (int)((i / 3840) % 3), s = (int)(i / (3 * 3840));
        if (s < NBP) F.out[O_PCONV + (size_t)(s * 3 + j) * 3840 + c] = bf2f(((bf16*)(F.ws + WS_PROJ))[(size_t)(s * SEQ + SEQ - 3 + j) * PLD + c]);
        else { const int sb = s - NBP; F.out[O_SCONV + (size_t)(sb * 3 + j) * 3840 + c] = bf2f(((bf16*)(F.ws + WS_PROJ))[(size_t)(MPROMPT + sb * LSMP + 1 + j) * PLD + c]); } }
#pragma unroll
    for (int g = 0; g < 3; ++g) {
        const int W = g == 0 ? 128 : (g == 1 ? 512 : 2048);
        const size_t op = g == 0 ? O_PKV0 : (g == 1 ? O_PKV1 : O_PKV2), os = g == 0 ? O_SKV0 : (g == 1 ? O_SKV1 : O_SKV2);
        const float* cache = g == 0 ? (args.in[6]) : (g == 1 ? (args.in[7]) : (args.in[8]));
        const long np = (long)NBP * W * 128, ns = (long)NBS * W * 128;
        for (long i = gt; i < np + ns; i += NGT) {
            const bool smp = i >= np; const long q = smp ? i - np : i;
            const int e4 = (int)(q & 15), hs = (int)((q >> 4) & 3), kv = (int)((q >> 6) & 1), j = (int)((q >> 7) % W), s = (int)((q >> 7) / W);
            const int pcol = QB_OFF + (kv + 1) * BW + (g * HPG + hs) * HD + 4 * e4;
            f32x4 v;
            if (!smp) { const v2u w = *(const v2u*)(((bf16*)(F.ws + WS_PROJ)) + (size_t)(s * SEQ + SEQ - W + j) * PLD + pcol); v = (f32x4){bf_lo(w.x), bf_hi(w.x), bf_lo(w.y), bf_hi(w.y)};
                *(f32x4*)(F.out + op + (size_t)q * 4) = v; }
            else { if (j < W - LSMP) v = *(const f32x4*)(cache + (((size_t)(s * W + j + LSMP) * 2 + kv) * 4 + hs) * 64 + 4 * e4);
                else { const v2u w = *(const v2u*)(((bf16*)(F.ws + WS_PROJ)) + (size_t)(MPROMPT + s * LSMP + (j - (W - LSMP))) * PLD + pcol); v = (f32x4){bf_lo(w.x), bf_hi(w.x), bf_lo(w.y), bf_hi(w.y)}; }
                *(f32x4*)(F.out + os + (size_t)q * 4) = v; }
        }
    }
}
__device__ __forceinline__ void gdn_scan_naive(Frame& F, const Args& args) {
    LAS bf16* Kb = (LAS bf16*)(F.lds + RING_OFF);
    LAS bf16* Qb = (LAS bf16*)(F.lds + RING_OFF + 16384);
    LAS bf16* Vb = (LAS bf16*)(F.lds + RING_OFF + 32768);
    LAS float* gb = (LAS float*)(F.lds + RING_OFF + 40960);
    LAS float* bb = gb + 64;
    for (int task = 2 * NBP * AH + (F.G - 1 - F.vcu); task < 200; task += F.G) {
        const int chain = task >> 1, hf = task & 1;
        const bool smp = chain >= NBP * AH;
        const int seq = smp ? NBP + (chain - NBP * AH) / AH : chain / AH, h = smp ? (chain - NBP * AH) % AH : chain % AH;
        const int L = smp ? LSMP : SEQ, m0 = smp ? MPROMPT + (seq - NBP) * LSMP : seq * SEQ;
        const int vc = F.lane & 7, kg = F.lane >> 3, v0 = hf * 64 + F.wave * 8;
        float s[16];
        if (smp) {
#pragma unroll
            for (int i = 0; i < 16; ++i) s[i] = (args.in[4])[(((size_t)(seq - NBP) * AH + h) * 128 + kg * 16 + i) * 128 + v0 + vc];
        } else {
#pragma unroll
            for (int i = 0; i < 16; ++i) s[i] = 0.f;
        }
        for (int t0 = 0; t0 < L; t0 += 64) {
            const int nb = (L - t0) < 64 ? (L - t0) : 64;
            __syncthreads();
            for (int i = F.tid; i < nb * 16; i += NWAVES * 64) { const int tt = i >> 4, ch = i & 15; const bf16* rowp = ((bf16*)(F.ws + WS_QKVC)) + (size_t)(m0 + t0 + tt) * 3840 + h * ADK + 8 * ch;
                *(LAS v4u*)(Qb + tt * 128 + 8 * ch) = *(const v4u*)rowp; *(LAS v4u*)(Kb + tt * 128 + 8 * ch) = *(const v4u*)(rowp + AW);
                if (ch < 8) *(LAS v4u*)(Vb + tt * 64 + 8 * ch) = *(const v4u*)(rowp + 2 * AW + hf * 64); }
            if (F.tid < nb) { gb[F.tid] = __expf(((float*)(F.ws + WS_G))[(size_t)(m0 + t0 + F.tid) * AH + h]); bb[F.tid] = ((float*)(F.ws + WS_BETA))[(size_t)(m0 + t0 + F.tid) * AH + h]; }
            __syncthreads();
            for (int tt = 0; tt < nb; ++tt) {
                const float a = gb[tt], be = bb[tt];
                const v4u k0 = *(const LAS v4u*)(Kb + tt * 128 + kg * 16), k1 = *(const LAS v4u*)(Kb + tt * 128 + kg * 16 + 8);
                const v4u q0 = *(const LAS v4u*)(Qb + tt * 128 + kg * 16), q1 = *(const LAS v4u*)(Qb + tt * 128 + kg * 16 + 8);
                const float vv = bf2f(Vb[tt * 64 + F.wave * 8 + vc]);
                float kf[16], qf[16];
                kf[0] = bf_lo(k0.x); kf[1] = bf_hi(k0.x); kf[2] = bf_lo(k0.y); kf[3] = bf_hi(k0.y); kf[4] = bf_lo(k0.z); kf[5] = bf_hi(k0.z); kf[6] = bf_lo(k0.w); kf[7] = bf_hi(k0.w);
                kf[8] = bf_lo(k1.x); kf[9] = bf_hi(k1.x); kf[10] = bf_lo(k1.y); kf[11] = bf_hi(k1.y); kf[12] = bf_lo(k1.z); kf[13] = bf_hi(k1.z); kf[14] = bf_lo(k1.w); kf[15] = bf_hi(k1.w);
                qf[0] = bf_lo(q0.x); qf[1] = bf_hi(q0.x); qf[2] = bf_lo(q0.y); qf[3] = bf_hi(q0.y); qf[4] = bf_lo(q0.z); qf[5] = bf_hi(q0.z); qf[6] = bf_lo(q0.w); qf[7] = bf_hi(q0.w);
                qf[8] = bf_lo(q1.x); qf[9] = bf_hi(q1.x); qf[10] = bf_lo(q1.y); qf[11] = bf_hi(q1.y); qf[12] = bf_lo(q1.z); qf[13] = bf_hi(q1.z); qf[14] = bf_lo(q1.w); qf[15] = bf_hi(q1.w);
                float part = 0.f;
#pragma unroll
                for (int i = 0; i < 16; ++i) { s[i] *= a; part += kf[i] * s[i]; }
                part += __shfl_xor(part, 8); part += __shfl_xor(part, 16); part += __shfl_xor(part, 32);
                const float dl = be * (vv - part);
                float op = 0.f;
#pragma unroll
                for (int i = 0; i < 16; ++i) { s[i] += kf[i] * dl; op += qf[i] * s[i]; }
                op += __shfl_xor(op, 8); op += __shfl_xor(op, 16); op += __shfl_xor(op, 32);
                if (kg == 0) ((float*)(F.ws + WS_OA))[(size_t)(m0 + t0 + tt) * AW + h * ADK + v0 + vc] = op;
            }
        }
        float* so = F.out + (smp ? O_SS + ((size_t)(seq - NBP) * AH + h) * 16384 : O_PS + ((size_t)seq * AH + h) * 16384);
#pragma unroll
        for (int i = 0; i < 16; ++i) so[(size_t)(kg * 16 + i) * 128 + v0 + vc] = s[i];
    }
    __syncthreads();
}

__device__ __forceinline__ void gdn_chunk_prep(Frame& F, const Args& args) {
    const int gw = F.vcu * NWAVES + F.wave, NGW = F.G * NWAVES;
    LAS float* ALDS = (LAS float*)(F.lds + RING_OFF + F.wave * 16384);
    LAS bf16* TL = (LAS bf16*)ALDS;
    LAS float* GAM = (LAS float*)(F.lds + SM_OFF + F.wave * SM_WAVE);
    LAS float* BET = GAM + 64;
    LAS float* EG = GAM + 128;
    LAS float* EGB = GAM + 192;
    LAS float* KDS = GAM + 256;
    const bf16* QKVC = (const bf16*)(F.ws + WS_QKVC);
    for (int u = gw; u < N_CHUNK_UNITS; u += NGW) {
        int l = F.lane; asm volatile("" : "+v"(l));
        const int r = l & 31, hh = l >> 5;
        const int chain = u >> 6, n = u & 63, b = chain / AH, h = chain % AH, mbase = b * SEQ + 64 * n;
        unsigned char* cb = F.ws + WS_CHK + (size_t)u * CHK_STRIDE;
        {
            const float gl = ((const float*)(F.ws + WS_G))[(size_t)(mbase + l) * AH + h], bl = ((const float*)(F.ws + WS_BETA))[(size_t)(mbase + l) * AH + h];
            float gam = gl;
#pragma unroll
            for (int off = 1; off < 64; off <<= 1) { const float t = __shfl_up(gam, off); if (l >= off) gam += t; }
            const float glast = __shfl(gam, 63);
            const float eg = __expf(gam);
            GAM[l] = gam; BET[l] = bl; EG[l] = eg; EGB[l] = bl * eg; KDS[l] = __expf(glast - gam);
            if (l == 63) ((float*)(F.ws + WS_GT))[u] = eg;
        }
        LDS_WAIT(); asm volatile("" ::: "memory");
        const bf16* qp = QKVC + (size_t)(mbase + r) * 3840 + h * ADK + 8 * hh;
        {
            f32x16 KK00, KK10, KK11;
#pragma unroll
            for (int i = 0; i < 16; ++i) { KK00[i] = 0.f; KK10[i] = 0.f; KK11[i] = 0.f; }
#pragma unroll 4
            for (int s = 0; s < 8; ++s) {
                const bf16x8s kf0 = *(const bf16x8s*)(qp + AW + 16 * s), kf1 = *(const bf16x8s*)(qp + AW + 32 * 3840 + 16 * s);
                KK00 = MFMA32(kf0, kf0, KK00); KK10 = MFMA32(kf1, kf0, KK10); KK11 = MFMA32(kf1, kf1, KK11);
            }
#define GDN_A_TILE(acc, mt, nt) do { const int col = 32 * (nt) + r; const float gamc = GAM[col]; \
            _Pragma("unroll") for (int i4 = 0; i4 < 4; ++i4) { const int rb = 32 * (mt) + 8 * i4 + 4 * hh; const f32x4 gr = *(const LAS f32x4*)(GAM + rb), br = *(const LAS f32x4*)(BET + rb); \
                _Pragma("unroll") for (int e = 0; e < 4; ++e) { const int row = rb + e; ALDS[row * 64 + col] = row > col ? br[e] * acc[4 * i4 + e] * __expf(gr[e] - gamc) : 0.f; } } } while (0)
            GDN_A_TILE(KK00, 0, 0); GDN_A_TILE(KK10, 1, 0); GDN_A_TILE(KK11, 1, 1);
#undef GDN_A_TILE
        }
        asm volatile("" ::: "memory");
        {
            f32x16 KQ00, KQ01, KQ11;
#pragma unroll
            for (int i = 0; i < 16; ++i) { KQ00[i] = 0.f; KQ01[i] = 0.f; KQ11[i] = 0.f; }
#pragma unroll 4
            for (int s = 0; s < 8; ++s) {
                const bf16x8s kf0 = *(const bf16x8s*)(qp + AW + 16 * s), kf1 = *(const bf16x8s*)(qp + AW + 32 * 3840 + 16 * s);
                const bf16x8s qf0 = *(const bf16x8s*)(qp + 16 * s), qf1 = *(const bf16x8s*)(qp + 32 * 3840 + 16 * s);
                KQ00 = MFMA32(kf0, qf0, KQ00); KQ01 = MFMA32(kf0, qf1, KQ01); KQ11 = MFMA32(kf1, qf1, KQ11);
            }
            bf16* QK = (bf16*)(cb + CHK_QK);
#define GDN_QK_TILE(acc, jt, it, zero) do { const int i_ = 32 * (it) + r; const float gami = GAM[i_]; \
            _Pragma("unroll") for (int i4 = 0; i4 < 4; ++i4) { const int j4 = 32 * (jt) + 8 * i4 + 4 * hh; const f32x4 gj = *(const LAS f32x4*)(GAM + j4); float x[4]; \
                _Pragma("unroll") for (int e = 0; e < 4; ++e) x[e] = (!(zero) && i_ >= j4 + e) ? acc[4 * i4 + e] * __expf(gami - gj[e]) : 0.f; \
                v2u w; w.x = cvtpk(x[0], x[1]); w.y = cvtpk(x[2], x[3]); *(v2u*)(QK + (size_t)i_ * 64 + pos4(j4)) = w; } } while (0)
            GDN_QK_TILE(KQ00, 0, 0, false); GDN_QK_TILE(KQ01, 0, 1, false); GDN_QK_TILE(KQ11, 1, 1, false); GDN_QK_TILE(KQ00, 1, 0, true);
#undef GDN_QK_TILE
        }
        LDS_WAIT(); asm volatile("" ::: "memory");
        float t[64];
#pragma unroll
        for (int i = 0; i < 64; ++i) {
            float s0 = 0.f;
#pragma unroll
            for (int jq = 0; jq < (i + 3) / 4; ++jq) { const f32x4 a = *(const LAS f32x4*)(ALDS + i * 64 + 4 * jq);
#pragma unroll
                for (int e = 0; e < 4; ++e) if (4 * jq + e < i) s0 = __builtin_fmaf(a[e], t[4 * jq + e], s0); }
            t[i] = (l == i ? 1.f : 0.f) - s0;
        }
        asm volatile("" ::: "memory");
        {
            const int pc = pos4(l & ~3) + (l & 3);
#pragma unroll
            for (int i = 0; i < 64; i += 2) { const unsigned w = cvtpk(t[i], t[i + 1]); TL[i * 72 + pc] = (bf16)(w & 0xffffu); TL[(i + 1) * 72 + pc] = (bf16)(w >> 16); }
        }
        LDS_WAIT(); asm volatile("" ::: "memory");
#define GDN_TFRAG(mt, S4) (*(const LAS bf16x8s*)(TL + (32 * (mt) + r) * 72 + 16 * (S4) + 8 * hh))
        bf16x8s idf[2];
#pragma unroll
        for (int s = 0; s < 2; ++s) { v4u w;
            w.x = (16 * s + 8 * hh + 0 == r ? 0x3F80u : 0u) | (16 * s + 8 * hh + 1 == r ? 0x3F800000u : 0u); w.y = (16 * s + 8 * hh + 2 == r ? 0x3F80u : 0u) | (16 * s + 8 * hh + 3 == r ? 0x3F800000u : 0u);
            w.z = (16 * s + 8 * hh + 4 == r ? 0x3F80u : 0u) | (16 * s + 8 * hh + 5 == r ? 0x3F800000u : 0u); w.w = (16 * s + 8 * hh + 6 == r ? 0x3F80u : 0u) | (16 * s + 8 * hh + 7 == r ? 0x3F800000u : 0u);
            idf[s] = __builtin_bit_cast(bf16x8s, w); }
#pragma unroll 1
        for (int vs = 0; vs < 4; ++vs) {
            bf16x8s bfr[2][2];
#pragma unroll
            for (int tt = 0; tt < 2; ++tt) {
                f32x16 X;
#pragma unroll
                for (int i = 0; i < 16; ++i) X[i] = 0.f;
#pragma unroll
                for (int s = 0; s < 2; ++s) X = MFMA32(*(const bf16x8s*)(qp + 2 * AW + (size_t)tt * 32 * 3840 + 32 * vs + 16 * s), idf[s], X);
#pragma unroll
                for (int s = 0; s < 2; ++s) { const f32x4 b0 = *(const LAS f32x4*)(BET + 32 * tt + 16 * s + 4 * hh), b1 = *(const LAS f32x4*)(BET + 32 * tt + 16 * s + 8 + 4 * hh);
                    const float x[8] = {X[8 * s + 0] * b0[0], X[8 * s + 1] * b0[1], X[8 * s + 2] * b0[2], X[8 * s + 3] * b0[3], X[8 * s + 4] * b1[0], X[8 * s + 5] * b1[1], X[8 * s + 6] * b1[2], X[8 * s + 7] * b1[3]};
                    bfr[tt][s] = pack8(x); }
            }
#pragma unroll
            for (int mt = 0; mt < 2; ++mt) {
                f32x16 U;
#pragma unroll
                for (int i = 0; i < 16; ++i) U[i] = 0.f;
#pragma unroll
                for (int S4 = 0; S4 < 4; ++S4) U = MFMA32(GDN_TFRAG(mt, S4), bfr[S4 >> 1][S4 & 1], U);
#pragma unroll
                for (int q = 0; q < 4; ++q) *(f32x4*)(cb + ((size_t)((vs * 2 + mt) * 4 + q) * 64 + l) * 16) = (f32x4){U[4 * q], U[4 * q + 1], U[4 * q + 2], U[4 * q + 3]};
            }
        }
#pragma unroll 1
        for (int kt = 0; kt < 4; ++kt) {
            bf16x8s afr[2][2];
            bf16* KD = (bf16*)(cb + CHK_KD); bf16* WN = (bf16*)(cb + CHK_WN);
#pragma unroll
            for (int tt = 0; tt < 2; ++tt) {
                f32x16 X;
#pragma unroll
                for (int i = 0; i < 16; ++i) X[i] = 0.f;
#pragma unroll
                for (int s = 0; s < 2; ++s) X = MFMA32(*(const bf16x8s*)(qp + AW + (size_t)tt * 32 * 3840 + 32 * kt + 16 * s), idf[s], X);
#pragma unroll
                for (int i4 = 0; i4 < 4; ++i4) { const int j4 = 32 * tt + 8 * i4 + 4 * hh; const f32x4 kd = *(const LAS f32x4*)(KDS + j4);
                    v2u w; w.x = cvtpk(X[4 * i4] * kd[0], X[4 * i4 + 1] * kd[1]); w.y = cvtpk(X[4 * i4 + 2] * kd[2], X[4 * i4 + 3] * kd[3]);
                    *(v2u*)(KD + (size_t)(32 * kt + r) * 64 + pos4(j4)) = w; }
#pragma unroll
                for (int s = 0; s < 2; ++s) { const f32x4 b0 = *(const LAS f32x4*)(EGB + 32 * tt + 16 * s + 4 * hh), b1 = *(const LAS f32x4*)(EGB + 32 * tt + 16 * s + 8 + 4 * hh);
                    const float x[8] = {X[8 * s + 0] * b0[0], X[8 * s + 1] * b0[1], X[8 * s + 2] * b0[2], X[8 * s + 3] * b0[3], X[8 * s + 4] * b1[0], X[8 * s + 5] * b1[1], X[8 * s + 6] * b1[2], X[8 * s + 7] * b1[3]};
                    afr[tt][s] = pack8(x); }
            }
#pragma unroll
            for (int it = 0; it < 2; ++it) {
                f32x16 WT;
#pragma unroll
                for (int i = 0; i < 16; ++i) WT[i] = 0.f;
#pragma unroll
                for (int S4 = 0; S4 < 4; ++S4) WT = MFMA32(afr[S4 >> 1][S4 & 1], GDN_TFRAG(it, S4), WT);
#pragma unroll
                for (int i4 = 0; i4 < 4; ++i4) { const int k4 = 32 * kt + 8 * i4 + 4 * hh;
                    v2u w; w.x = cvtpk(-WT[4 * i4], -WT[4 * i4 + 1]); w.y = cvtpk(-WT[4 * i4 + 2], -WT[4 * i4 + 3]);
                    *(v2u*)(WN + (size_t)(32 * it + r) * 128 + pos4(k4)) = w; }
            }
        }
#undef GDN_TFRAG
        {
            bf16* QD = (bf16*)(cb + CHK_QD); const int chn = l & 15;
#pragma unroll 4
            for (int itr = 0; itr < 16; ++itr) { const int i = 4 * itr + (l >> 4); const float eg = EG[i];
                const v4u qv = *(const v4u*)(QKVC + (size_t)(mbase + i) * 3840 + h * ADK + 8 * chn);
                v2u lo, hi; lo.x = cvtpk(bf_lo(qv.x) * eg, bf_hi(qv.x) * eg); lo.y = cvtpk(bf_lo(qv.y) * eg, bf_hi(qv.y) * eg); hi.x = cvtpk(bf_lo(qv.z) * eg, bf_hi(qv.z) * eg); hi.y = cvtpk(bf_lo(qv.w) * eg, bf_hi(qv.w) * eg);
                bf16* dst = QD + (size_t)i * 128 + 16 * (chn >> 1) + ((chn & 1) ? 4 : 0);
                *(v2u*)dst = lo; *(v2u*)(dst + 8) = hi; }
        }
        LDS_WAIT(); asm volatile("" ::: "memory");
    }
}

__device__ __forceinline__ void gdn_chunk_scan(Frame& F, const Args& args) {
    if (F.wave != 0) return;
    const int l = F.lane, r = l & 31, hh = l >> 5;
    for (int task = F.vcu; task < NBP * AH * 4; task += F.G) {
        const int chain = task >> 2, vs = task & 3, b = chain / AH, h = chain % AH;
        const unsigned char* cb0 = F.ws + WS_CHK + (size_t)chain * 64 * CHK_STRIDE;
        const float gtv = ((const float*)(F.ws + WS_GT))[chain * 64 + l];
        const unsigned offU = (unsigned)((vs * 8) * 64 + l) * 16u;
        const unsigned offW = (unsigned)CHK_WN + (unsigned)(r * 128 + 8 * hh) * 2u;
        const unsigned offQ = (unsigned)CHK_QD + (unsigned)(r * 128 + 8 * hh) * 2u;
        const unsigned offK = (unsigned)CHK_QK + (unsigned)(r * 64 + 8 * hh) * 2u;
        const unsigned offD = (unsigned)CHK_KD + (unsigned)(r * 64 + 8 * hh) * 2u;
#define GDN_DMA(src, slot, bufb) __builtin_amdgcn_global_load_lds((const unsigned*)(src), (LAS unsigned*)(F.lds + RING_OFF + (bufb) * 65536 + (slot) * 1024), 16, 0, 0)
#define GDN_ISSUE(n_, bufb) do { const unsigned char* cbn = cb0 + (size_t)(n_) * CHK_STRIDE; \
            _Pragma("unroll 1") for (int sl = 0; sl < 8; ++sl) GDN_DMA(cbn + offU + sl * 1024, sl, bufb); \
            _Pragma("unroll 1") for (int j = 0; j < 16; ++j) { GDN_DMA(cbn + offW + (j >> 3) * 8192 + (j & 7) * 32, 8 + j, bufb); GDN_DMA(cbn + offQ + (j >> 3) * 8192 + (j & 7) * 32, 24 + j, bufb); } \
            _Pragma("unroll 1") for (int j = 0; j < 8; ++j) GDN_DMA(cbn + offK + (j >> 2) * 4096 + (j & 3) * 32, 40 + j, bufb); \
            _Pragma("unroll 1") for (int j = 0; j < 16; ++j) GDN_DMA(cbn + offD + (j >> 2) * 4096 + (j & 3) * 32, 48 + j, bufb); } while (0)
        f32x16 Sacc[4];
#pragma unroll
        for (int kt = 0; kt < 4; ++kt)
#pragma unroll
            for (int i = 0; i < 16; ++i) Sacc[kt][i] = 0.f;
        GDN_ISSUE(0, 0);
        float* OA = (float*)(F.ws + WS_OA) + (size_t)(b * SEQ) * AW + h * ADK + 32 * vs + r;
#pragma unroll 1
        for (int n = 0; n < 64; ++n) {
            asm volatile("s_waitcnt vmcnt(0)" ::: "memory");
            if (n + 1 < 64) { const int nb_ = (n + 1) & 1; GDN_ISSUE(n + 1, nb_); }
            __builtin_amdgcn_sched_barrier(0);
            const float gt = __builtin_bit_cast(float, __builtin_amdgcn_readlane(__builtin_bit_cast(int, gtv), n));
            const LAS unsigned char* B = F.lds + RING_OFF + (n & 1) * 65536 + l * 16;
#define GDN_SLOT(sl) (*(const LAS bf16x8s*)(B + (sl) * 1024))
            bf16x8s Sb[4][2];
#pragma unroll
            for (int kt = 0; kt < 4; ++kt)
#pragma unroll
                for (int s = 0; s < 2; ++s) { const float x[8] = {Sacc[kt][8 * s], Sacc[kt][8 * s + 1], Sacc[kt][8 * s + 2], Sacc[kt][8 * s + 3], Sacc[kt][8 * s + 4], Sacc[kt][8 * s + 5], Sacc[kt][8 * s + 6], Sacc[kt][8 * s + 7]}; Sb[kt][s] = pack8(x); }
            f32x16 Up[2];
#pragma unroll
            for (int mt = 0; mt < 2; ++mt)
#pragma unroll
                for (int q = 0; q < 4; ++q) { const f32x4 uq = *(const LAS f32x4*)(B + (mt * 4 + q) * 1024); Up[mt][4 * q] = uq[0]; Up[mt][4 * q + 1] = uq[1]; Up[mt][4 * q + 2] = uq[2]; Up[mt][4 * q + 3] = uq[3]; }
#pragma unroll
            for (int S8 = 0; S8 < 8; ++S8)
#pragma unroll
                for (int mt = 0; mt < 2; ++mt) Up[mt] = MFMA32(GDN_SLOT(8 + mt * 8 + S8), Sb[S8 >> 1][S8 & 1], Up[mt]);
            bf16x8s Ub[2][2];
#pragma unroll
            for (int mt = 0; mt < 2; ++mt)
#pragma unroll
                for (int s = 0; s < 2; ++s) { const float x[8] = {Up[mt][8 * s], Up[mt][8 * s + 1], Up[mt][8 * s + 2], Up[mt][8 * s + 3], Up[mt][8 * s + 4], Up[mt][8 * s + 5], Up[mt][8 * s + 6], Up[mt][8 * s + 7]}; Ub[mt][s] = pack8(x); }
            {
                f32x16 O[2];
#pragma unroll
                for (int mt = 0; mt < 2; ++mt)
#pragma unroll
                    for (int i = 0; i < 16; ++i) O[mt][i] = 0.f;
#pragma unroll
                for (int S8 = 0; S8 < 8; ++S8)
#pragma unroll
                    for (int mt = 0; mt < 2; ++mt) O[mt] = MFMA32(GDN_SLOT(24 + mt * 8 + S8), Sb[S8 >> 1][S8 & 1], O[mt]);
#pragma unroll
                for (int S4 = 0; S4 < 4; ++S4)
#pragma unroll
                    for (int mt = 0; mt < 2; ++mt) if (S4 < 2 * (mt + 1)) O[mt] = MFMA32(GDN_SLOT(40 + mt * 4 + S4), Ub[S4 >> 1][S4 & 1], O[mt]);
#pragma unroll
                for (int mt = 0; mt < 2; ++mt)
#pragma unroll
                    for (int i = 0; i < 16; ++i) OA[(size_t)(64 * n + 32 * mt + (i & 3) + 8 * (i >> 2) + 4 * hh) * AW] = O[mt][i];
            }
#pragma unroll
            for (int kt = 0; kt < 4; ++kt)
#pragma unroll
                for (int i = 0; i < 16; ++i) Sacc[kt][i] *= gt;
#pragma unroll
            for (int S4 = 0; S4 < 4; ++S4)
#pragma unroll
                for (int kt = 0; kt < 4; ++kt) Sacc[kt] = MFMA32(GDN_SLOT(48 + kt * 4 + S4), Ub[S4 >> 1][S4 & 1], Sacc[kt]);
#undef GDN_SLOT
        }
        float* so = F.out + O_PS + (size_t)chain * 16384 + 32 * vs + r;
#pragma unroll
        for (int kt = 0; kt < 4; ++kt)
#pragma unroll
            for (int i = 0; i < 16; ++i) so[(size_t)(32 * kt + (i & 3) + 8 * (i >> 2) + 4 * hh) * 128] = Sacc[kt][i];
        asm volatile("s_waitcnt vmcnt(0)" ::: "memory");
#undef GDN_DMA
#undef GDN_ISSUE
    }
}

__device__ __forceinline__ void mixer0_gate(Frame& F, const Args& args) {
    const int gw = F.vcu * NWAVES + F.wave, NGW = F.G * NWAVES;
    const f32x2 on = *(const f32x2*)((args.in[22]) + 2 * F.lane);
    for (int m = gw; m < MV; m += NGW) {
        bf16* mrow = ((bf16*)(F.ws + WS_MIX)) + (size_t)m * D;
#pragma unroll 2
        for (int h = 0; h < AH; ++h) { const f32x2 o = *(const f32x2*)(((float*)(F.ws + WS_OA)) + (size_t)m * AW + h * ADK + 2 * F.lane);
            const float rs = 1.0f / sqrtf(wave_sum(o.x * o.x + o.y * o.y) * (1.0f / 128.0f) + EPS);
            const unsigned zw = *(const unsigned*)(((bf16*)(F.ws + WS_PROJ)) + (size_t)m * PLD + 3840 + h * ADK + 2 * F.lane); const float z0 = bf_lo(zw), z1 = bf_hi(zw);
            *(unsigned*)(mrow + h * ADK + 2 * F.lane) = pk2(o.x * rs * on.x * (z0 / (1.0f + __expf(-z0))), o.y * rs * on.y * (z1 / (1.0f + __expf(-z1)))); }
#pragma unroll
        for (int hs = 0; hs < HPG; ++hs) { const float l0 = ((float*)(F.ws + WS_LSE))[(size_t)m * 12 + hs], l1 = ((float*)(F.ws + WS_LSE))[(size_t)m * 12 + 4 + hs], l2 = ((float*)(F.ws + WS_LSE))[(size_t)m * 12 + 8 + hs];
            const float mx = fmaxf(fmaxf(l0, l1), l2), e0 = __expf(l0 - mx), e1 = __expf(l1 - mx), e2 = __expf(l2 - mx), rs = 1.0f / (e0 + e1 + e2);
            const float al[3] = {e0 * rs, e1 * rs, e2 * rs};
#pragma unroll
            for (int g = 0; g < 3; ++g) { const int col = (g * HPG + hs) * HD + F.lane; mrow[AW + col] = (bf16)f2bf(((float*)(F.ws + WS_OB))[(size_t)m * BW + col] * al[g]); } }
    }
}
__device__ __forceinline__ void mixer1_conv(Frame& F, const Args& args) {
    const bf16* BG = ((bf16*)(F.ws + WS_PROJ)); const bf16* P = ((bf16*)(F.ws + WS_PROJ)) + (size_t)MP * D;
    const long gt = (long)F.vcu * (NWAVES * 64) + F.tid, NGT = (long)F.G * NWAVES * 64;
    for (long i = gt; i < (long)MV * 256; i += NGT) {
        const int m = (int)(i >> 8), c = (int)(i & 255) * 8;
        const bool smp = m >= MPROMPT; const int t = smp ? ((m - MPROMPT) & 3) : (m & (SEQ - 1)); const int sb = smp ? ((m - MPROMPT) >> 2) : 0;
        float y[8];
#pragma unroll
        for (int e = 0; e < 8; ++e) y[e] = 0.f;
#pragma unroll
        for (int j = 0; j < 3; ++j) { const int tt = t - 2 + j; float pv[8];
            if (tt >= 0) { const v4u w = *(const v4u*)(P + (size_t)(m - t + tt) * D + c); pv[0] = bf_lo(w.x); pv[1] = bf_hi(w.x); pv[2] = bf_lo(w.y); pv[3] = bf_hi(w.y); pv[4] = bf_lo(w.z); pv[5] = bf_hi(w.z); pv[6] = bf_lo(w.w); pv[7] = bf_hi(w.w); }
            else if (smp) { const float* sp = (args.in[9]) + (size_t)(sb * 2 + (2 + tt)) * D + c; const f32x4 a = *(const f32x4*)sp, b = *(const f32x4*)(sp + 4);
                pv[0] = a.x; pv[1] = a.y; pv[2] = a.z; pv[3] = a.w; pv[4] = b.x; pv[5] = b.y; pv[6] = b.z; pv[7] = b.w; }
            else {
#pragma unroll
                for (int e = 0; e < 8; ++e) pv[e] = 0.f; }
            const f32x4 w0 = *(const f32x4*)((args.in[25]) + (size_t)j * D + c), w1 = *(const f32x4*)((args.in[25]) + (size_t)j * D + c + 4);
            y[0] += w0.x * pv[0]; y[1] += w0.y * pv[1]; y[2] += w0.z * pv[2]; y[3] += w0.w * pv[3]; y[4] += w1.x * pv[4]; y[5] += w1.y * pv[5]; y[6] += w1.z * pv[6]; y[7] += w1.w * pv[7]; }
        const v4u bw = *(const v4u*)(BG + (size_t)m * D + c);
        v4u o; o.x = pk2(bf_lo(bw.x) * y[0], bf_hi(bw.x) * y[1]); o.y = pk2(bf_lo(bw.y) * y[2], bf_hi(bw.y) * y[3]); o.z = pk2(bf_lo(bw.z) * y[4], bf_hi(bw.z) * y[5]); o.w = pk2(bf_lo(bw.w) * y[6], bf_hi(bw.w) * y[7]);
        *(v4u*)(((bf16*)(F.ws + WS_MIX)) + (size_t)m * D + c) = o;
    }
    for (long i = gt; i < (long)(NBP + NBS) * 2 * D; i += NGT) { const int c = (int)(i % D), j = (int)((i / D) % 2), s = (int)(i / (2 * D));
        if (s < NBP) F.out[O_PSC + (size_t)(s * 2 + j) * D + c] = bf2f(P[(size_t)(s * SEQ + SEQ - 2 + j) * D + c]);
        else { const int sb = s - NBP; F.out[O_SSC + (size_t)(sb * 2 + j) * D + c] = bf2f(P[(size_t)(MPROMPT + sb * LSMP + 2 + j) * D + c]); } }
}


template <int MODE, int KSPLIT, int NSB>
__device__ __forceinline__ void skinny_phase(Frame& F, const bf16* Abase, const bf16* Bt, const int K, const int ntasks, const float* gate, const float scale) {
    static_assert(KSPLIT == 1 || MODE == 1, "only the residual epilogue accumulates");
    LAS float* T = (LAS float*)(F.lds + RING_OFF);
    const int r = F.lane & 31, h = F.lane >> 5, kw = K / (8 * KSPLIT), ns = kw >> 4;
    unsigned char* ws = F.ws;
    for (int tk_ = F.G - 1 - (int)blockIdx.x; tk_ < ntasks * KSPLIT; tk_ += F.G) {
        const int tsk = tk_ / KSPLIT, kq = tk_ % KSPLIT;
        int row0, row1;
        if (MODE == 0) { row0 = 256 * (tsk >> 2) + 32 * (tsk & 3); row1 = row0 + 128; }
        else if (MODE == 3 && tsk >= 32) { const int j = tsk - 32; row0 = 256 * (8 + (j >> 2)) + 32 * (j & 3); row1 = row0 + 128; }
        else { row0 = 64 * tsk; row1 = row0 + 32; }
        const int kbeg = (kq * 8 + F.wave) * kw + 8 * h;
        const bf16* w0 = Bt + (size_t)(row0 + r) * K + kbeg;
        const bf16* w1 = Bt + (size_t)(row1 + r) * K + kbeg;
        const bf16* tk = Abase + (size_t)(MPROMPT + r) * K + kbeg;
        f32x16 acc0, acc1;
#pragma unroll
        for (int i = 0; i < 16; ++i) { acc0[i] = 0.f; acc1[i] = 0.f; }
#pragma unroll 1
        for (int s0 = 0; s0 < ns; s0 += NSB) {
            bf16x8s a0[NSB], a1[NSB], bb[NSB];
#pragma unroll
            for (int s = 0; s < NSB; ++s) { a0[s] = *(const bf16x8s*)(w0 + 16 * (s0 + s)); a1[s] = *(const bf16x8s*)(w1 + 16 * (s0 + s)); bb[s] = *(const bf16x8s*)(tk + 16 * (s0 + s)); }
#pragma unroll
            for (int s = 0; s < NSB; ++s) { acc0 = __builtin_amdgcn_mfma_f32_32x32x16_bf16(a0[s], bb[s], acc0, 0, 0, 0); acc1 = __builtin_amdgcn_mfma_f32_32x32x16_bf16(a1[s], bb[s], acc1, 0, 0, 0); }
        }
        __syncthreads();
#pragma unroll
        for (int i = 0; i < 16; ++i) { const int n = (i & 3) + 8 * (i >> 2) + 4 * h;
            T[((F.wave * 2 + 0) * 32 + n) * 32 + r] = acc0[i]; T[((F.wave * 2 + 1) * 32 + n) * 32 + r] = acc1[i]; }
        __syncthreads();
        const int tok = F.tid & 31, n0 = 2 * (F.tid >> 5), row = MPROMPT + tok;
        float v[2][2];
#pragma unroll
        for (int t = 0; t < 2; ++t)
#pragma unroll
            for (int e = 0; e < 2; ++e) { float a = 0.f;
#pragma unroll
                for (int w = 0; w < 8; ++w) a += T[((w * 2 + t) * 32 + n0 + e) * 32 + tok];
                v[t][e] = a; }
        if (MODE == 0) { const int ocol = (row0 >> 8) * 128 + (row0 & 127) + n0;
            *(unsigned*)((bf16*)(ws + WS_ACT) + (size_t)row * FF + ocol) = pk2(pg8::silu_f(v[0][0]) * v[1][0], pg8::silu_f(v[0][1]) * v[1][1]); }
        else if (MODE == 1) { const int seq = pg8::seq_of_row(row);
#pragma unroll
            for (int t = 0; t < 2; ++t) { const int col = (t ? row1 : row0) + n0; float* xp = (float*)(ws + WS_X) + (size_t)row * D + col; const float* gp = gate + (size_t)seq * NMOD + col;
                const f32x2 gv = *(const f32x2*)gp;
                if (KSPLIT == 1) { f32x2 xv = *(f32x2*)xp; xv.x += scale * gv.x * v[t][0]; xv.y += scale * gv.y * v[t][1]; *(f32x2*)xp = xv; }
                else { __hip_atomic_fetch_add(xp, scale * gv.x * v[t][0], __ATOMIC_RELAXED, __HIP_MEMORY_SCOPE_AGENT); __hip_atomic_fetch_add(xp + 1, scale * gv.y * v[t][1], __ATOMIC_RELAXED, __HIP_MEMORY_SCOPE_AGENT); } } }
        else if (MODE == 2) {
            if (row0 < PLD) {
#pragma unroll
                for (int t = 0; t < 2; ++t) *(unsigned*)((bf16*)(ws + WS_PROJ) + (size_t)row * PLD + (t ? row1 : row0) + n0) = pk2(v[t][0], v[t][1]); }
            else { *(f32x2*)((float*)(ws + WS_AB) + (size_t)row * 32 + n0) = (f32x2){v[0][0], v[0][1]}; } }
        else {
            if (row0 < D) {
#pragma unroll
                for (int t = 0; t < 2; ++t) *(unsigned*)((bf16*)(ws + WS_PROJ) + (size_t)row * D + (t ? row1 : row0) + n0) = pk2(v[t][0], v[t][1]); }
            else { const int pcol = ((row0 >> 8) - 8) * 128 + (row0 & 127) + n0;
                *(unsigned*)((bf16*)(ws + WS_PROJ) + (size_t)MP * D + (size_t)row * D + pcol) = pk2(v[0][0] * v[1][0], v[0][1] * v[1][1]); } }
    }
    __syncthreads();
}

#define IN_PH() (lo <= pid && pid < hi)
#define SEAM() do { if (MK_N_LAUNCHES == 1 && lo <= pid && pid + 1 < hi) xcd_barrier(bar); ++pid; } while (0)
template <int L, int SUB>
__device__ __forceinline__ void sublayer(Frame& F, const Args& args, const XcdBarrier& bar, int& pid, const int lo, const int hi) {
    unsigned char* ws = F.ws;
    const float* modl = (const float*)(ws + WS_MOD) + (size_t)L * NSEQ * NMOD;
    if (IN_PH()) { const float* gain = args.in[SUB == 0 ? 12 : (SUB == 1 ? 13 : 14)] + (size_t)L * D;
        norm_phase(F, args, gain, modl + (size_t)(3 * SUB) * D, modl + (size_t)(3 * SUB + 1) * D, L == 0 && SUB == 0); }
    SEAM();
    if constexpr (SUB != 1) {
        constexpr int f = SUB >> 1;
        if (IN_PH()) { pg8::Gemm g{(const pg8::bf16_t*)(ws + WS_H), (const pg8::bf16_t*)(ws + WS_WUP + (size_t)(L * 2 + f) * WUP_STRIDE), MPROMPT, NUP, D}; pg8::StaticOrder S; S.init(MPROMPT, NUP, F.G, (int)blockIdx.x);
            pg8::EpiSwiglu E{(pg8::bf16_t*)(ws + WS_ACT), FF};
            pg8::gemm_phase<pg8::EpiSwiglu, pg8::StaticOrder, true, true>(F.lds + RING_OFF, g, S, E);
            skinny_phase<0, 1, 8>(F, (const bf16*)(ws + WS_H), (const bf16*)(ws + WS_WUP + (size_t)(L * 2 + f) * WUP_STRIDE), D, 176, nullptr, 0.f);
            if constexpr (L == 1) { if (f == 0) convert_slack(F, args, CV_SCAN, CV_T1, (int)blockIdx.x, 128, 4); else convert_slack(F, args, CV_T1, CV_END, (int)blockIdx.x, 128, 4); } }
        SEAM();
        if (IN_PH()) { pg8::Gemm g{(const pg8::bf16_t*)(ws + WS_ACT), (const pg8::bf16_t*)(ws + WS_WDN + (size_t)(L * 2 + f) * WDN_STRIDE), MPROMPT, D, FF}; pg8::StaticOrder S; S.init(MPROMPT, D, F.G, (int)blockIdx.x);
            pg8::EpiResid E{(float*)(ws + WS_X), modl + (size_t)(3 * SUB + 2) * D, 0.5f};
            pg8::gemm_phase<pg8::EpiResid, pg8::StaticOrder, true, true>(F.lds + RING_OFF, g, S, E);
            skinny_phase<1, 1, 11>(F, (const bf16*)(ws + WS_ACT), (const bf16*)(ws + WS_WDN + (size_t)(L * 2 + f) * WDN_STRIDE), FF, 32, modl + (size_t)(3 * SUB + 2) * D, 0.5f); }
        SEAM();
    } else {
        if constexpr (L == 0) {
            if (IN_PH()) { pg8::Gemm g{(const pg8::bf16_t*)(ws + WS_H), (const pg8::bf16_t*)(ws + WS_WIN0), MPROMPT, IN0P, D}; pg8::StaticOrder S; S.init(MPROMPT, IN0P, F.G, (int)blockIdx.x);
                pg8::EpiIn0 E{(pg8::bf16_t*)(ws + WS_PROJ), PLD, (float*)(ws + WS_AB)};
                pg8::gemm_phase<pg8::EpiIn0, pg8::StaticOrder, true, true>(F.lds + RING_OFF, g, S, E);
                skinny_phase<2, 1, 8>(F, (const bf16*)(ws + WS_H), (const bf16*)(ws + WS_WIN0), D, 117, nullptr, 0.f); }
            SEAM();
            if (IN_PH()) { gdn_prep(F, args); swa_prompt(F, args); swa_sample(F, args); mixer0_copies(F, args); }
            SEAM();
            if (IN_PH()) { gdn_chunk_prep(F, args); }
            SEAM();
            if (IN_PH()) { gdn_chunk_scan(F, args); __syncthreads(); gdn_scan_naive(F, args); convert_slack(F, args, CV_P0, CV_SCAN, F.vcu, NBP * AH * 4, 2); }
            SEAM();
            if (IN_PH()) { mixer0_gate(F, args); }
            SEAM();
        } else {
            if (IN_PH()) { pg8::Gemm g{(const pg8::bf16_t*)(ws + WS_H), (const pg8::bf16_t*)(ws + WS_WIN1), MPROMPT, IN1, D}; pg8::StaticOrder S; S.init(MPROMPT, IN1, F.G, (int)blockIdx.x);
                pg8::EpiIn1 E{(pg8::bf16_t*)(ws + WS_PROJ), (pg8::bf16_t*)(ws + WS_PROJ) + (size_t)MP * D};
                pg8::gemm_phase<pg8::EpiIn1, pg8::StaticOrder, true, true>(F.lds + RING_OFF, g, S, E);
                skinny_phase<3, 1, 8>(F, (const bf16*)(ws + WS_H), (const bf16*)(ws + WS_WIN1), D, 96, nullptr, 0.f); }
            SEAM();
            if (IN_PH()) { mixer1_conv(F, args); }
            SEAM();
        }
        if (IN_PH()) { pg8::Gemm g{(const pg8::bf16_t*)(ws + WS_MIX), (const pg8::bf16_t*)(ws + (L == 0 ? WS_WOUT0 : WS_WOUT1)), MPROMPT, D, D}; pg8::StaticOrder S; S.init(MPROMPT, D, F.G, (int)blockIdx.x);
            pg8::EpiResid E{(float*)(ws + WS_X), modl + (size_t)(3 * SUB + 2) * D, 1.0f};
            pg8::gemm_phase<pg8::EpiResid, pg8::StaticOrder, true, true>(F.lds + RING_OFF, g, S, E);
            skinny_phase<1, 1, 8>(F, (const bf16*)(ws + WS_MIX), (const bf16*)(ws + (L == 0 ? WS_WOUT0 : WS_WOUT1)), D, 32, modl + (size_t)(3 * SUB + 2) * D, 1.0f); }
        SEAM();
    }
}

__global__ void __launch_bounds__(NWAVES * 64, 2) fwd(Args args) {
    extern __shared__ __attribute__((aligned(16))) unsigned char lds[];
    Frame F;
    F.lds = (LAS unsigned char*)lds;
    F.MISC = (volatile LAS unsigned*)(F.lds + MISC_OFF);
    F.tid = threadIdx.x; F.lane = F.tid & 63; F.wave = __builtin_amdgcn_readfirstlane(F.tid >> 6);
    F.G = gridDim.x; { const int bx = blockIdx.x; F.vcu = (F.G % 8 == 0) ? (bx % 8) * (F.G / 8) + bx / 8 : bx; }
    F.ws = args.ws; F.out = args.out;
    F.ctl = (gu32*)(args.ws + WS_CTL);
    for (int u = F.tid; u < (LDS_BYTES - LDSCTL_OFF) / 4; u += NWAVES * 64) ((LAS unsigned*)(F.lds + LDSCTL_OFF))[u] = 0u;
    __syncthreads();
    XcdBarrier bar; bar.bar = (unsigned*)(F.ctl + CW_BAR); bar.x = 0; bar.st = nullptr;
    if (MK_N_LAUNCHES == 1) bar = xcd_barrier_post((unsigned*)(F.ctl + CW_BAR), F.MISC + 8);

    const int lo = args.ph_lo, hi = args.ph_hi;
    int pid = 0;
    if (IN_PH()) { p0_weights(F, args); p0_mod(F, args); }
    SEAM();
    sublayer<0, 0>(F, args, bar, pid, lo, hi);
    sublayer<0, 1>(F, args, bar, pid, lo, hi);
    sublayer<0, 2>(F, args, bar, pid, lo, hi);
    sublayer<1, 0>(F, args, bar, pid, lo, hi);
    sublayer<1, 1>(F, args, bar, pid, lo, hi);
    sublayer<1, 2>(F, args, bar, pid, lo, hi);
    if (IN_PH()) { final_norm_phase(F, args); }
}
#undef IN_PH
#undef SEAM
constexpr int N_PHASES = 1 + (3 + 3 + 4 + 3) + (3 + 3 + 3 + 1) + 1;

extern "C" void kernel_launch(void* const* d_in, const int* in_sizes, int n_in, void* d_out, int out_size, void* d_ws, size_t ws_size, hipStream_t stream) {
    static int grid = 0;
    if (grid == 0) {
        if (n_in != 27 || out_size != (int)O_END || ws_size < WS_END) { fprintf(stderr, "kernel_launch: expected 27 inputs, %zu outputs, >= %zu B workspace; got %d, %d, %zu\n", (size_t)O_END, (size_t)WS_END, n_in, out_size, ws_size); grid = -1; return; }
        int dev = 0, cus = 0, per_cu = 0;
        if (hipGetDevice(&dev) != hipSuccess || hipDeviceGetAttribute(&cus, hipDeviceAttributeMultiprocessorCount, dev) != hipSuccess) { fprintf(stderr, "kernel_launch: device query failed\n"); grid = -1; return; }
        if (hipFuncSetAttribute((const void*)fwd, hipFuncAttributeMaxDynamicSharedMemorySize, LDS_BYTES) != hipSuccess) { fprintf(stderr, "kernel_launch: hipFuncSetAttribute failed\n"); grid = -1; return; }
        if (hipOccupancyMaxActiveBlocksPerMultiprocessor(&per_cu, (const void*)fwd, NWAVES * 64, LDS_BYTES) != hipSuccess || per_cu < 1)
            fprintf(stderr, "kernel_launch: note: occupancy query reports %d workgroups per CU\n", per_cu);
        (void)hipGetLastError();
        grid = cus;
    }
    if (grid < 0) return;
    if (hipMemsetAsync((char*)d_ws + WS_CTL, 0, CTL_ZERO_BYTES, stream) != hipSuccess) { fprintf(stderr, "kernel_launch: memset failed\n"); return; }
    Args a{};
    for (int i = 0; i < 27; ++i) a.in[i] = (const float*)d_in[i];
    a.out = (float*)d_out; a.ws = (unsigned char*)d_ws;
    if (MK_N_LAUNCHES == 1) {
        a.ph_lo = 0; a.ph_hi = N_PHASES;
        hipLaunchKernelGGL(fwd, dim3(grid), dim3(NWAVES * 64), LDS_BYTES, stream, a);
    } else {
        for (int p = 0; p < N_PHASES; ++p) { a.ph_lo = p; a.ph_hi = p + 1; hipLaunchKernelGGL(fwd, dim3(grid), dim3(NWAVES * 64), LDS_BYTES, stream, a); }
    }
    const hipError_t le = hipPeekAtLastError();
    if (le != hipSuccess) fprintf(stderr, "kernel_launch: launch failed: %s\n", hipGetErrorName(le));
}
```
